# Optimizing an MI355X kernel written in HIP

```python
import jax, jax.numpy as jnp
from jax import lax
import numpy as np

D_MODEL = 1024
BATCH = 2
SEQ = 16384
DEPTH = 1
DEC_BATCH = 4
DEC_SEQ = 8192
PAST_LEN = 128

D_MIX = D_MODEL
RET_HEADS = 4
RET_HEAD_DIM = 128
RET_WIDTH = RET_HEADS * RET_HEAD_DIM
MLA_HEADS = 4
MLA_NOPE_DIM = 128
MLA_ROPE_DIM = 64
MLA_QK_DIM = MLA_NOPE_DIM + MLA_ROPE_DIM
MLA_V_DIM = 128
MLA_WIDTH = MLA_HEADS * MLA_V_DIM
Q_LORA = 384
KV_LORA = 256
D_FF = 4 * D_MODEL
D_IN = 4 * RET_WIDTH + Q_LORA + KV_LORA + MLA_ROPE_DIM
IN_SPLITS = (RET_WIDTH, 2 * RET_WIDTH, 3 * RET_WIDTH, 4 * RET_WIDTH,
             4 * RET_WIDTH + Q_LORA, 4 * RET_WIDTH + Q_LORA + KV_LORA)
CHUNK = 128
Q_BLOCK = 128
ROPE_BASE = 10000.0
LN_EPS = 1e-5
RMS_EPS = 1e-6
DEEPNORM_ALPHA = float((2 * DEPTH) ** 0.25)
DEEPNORM_BETA = float((8 * DEPTH) ** -0.25)
N_MOD = 6
MLA_SCALE = float(MLA_QK_DIM ** -0.5)

kernel_name = "hymba_retention_mla_deepnorm_adaln_encoder"


def layer_norm_plain(x):
    xf = x.astype(jnp.float32)
    mu = jnp.mean(xf, -1, keepdims=True)
    var = jnp.mean(jnp.square(xf - mu), -1, keepdims=True)
    return ((xf - mu) * lax.rsqrt(var + LN_EPS)).astype(x.dtype)


def layer_norm_affine(x, w, b):
    xf = x.astype(jnp.float32)
    mu = jnp.mean(xf, -1, keepdims=True)
    var = jnp.mean(jnp.square(xf - mu), -1, keepdims=True)
    return ((xf - mu) * lax.rsqrt(var + LN_EPS) * w + b).astype(x.dtype)


def rms_norm(x, w):
    xf = x.astype(jnp.float32)
    y = xf * lax.rsqrt(jnp.mean(xf * xf, -1, keepdims=True) + RMS_EPS)
    return (y * w).astype(x.dtype)


def apply_rotary(x):
    S, d = x.shape[1], x.shape[-1]
    inv = ROPE_BASE ** (-jnp.arange(0, d, 2, dtype=jnp.float32) / d)
    ang = jnp.arange(S, dtype=jnp.float32)[:, None] * inv[None, :]
    cos = jnp.cos(ang)[:, None, :]
    sin = jnp.sin(ang)[:, None, :]
    xf = x.astype(jnp.float32)
    x1, x2 = xf[..., : d // 2], xf[..., d // 2:]
    return jnp.concatenate([x1 * cos - x2 * sin, x1 * sin + x2 * cos], -1).astype(x.dtype)


def retention_chunkwise(q, k, v, log_gamma, include_diag):
    B, S, H, dk = q.shape
    dv = v.shape[-1]
    n = S // CHUNK
    idx = jnp.arange(CHUNK, dtype=jnp.float32)
    rel = idx[:, None] - idx[None, :]
    mask = (rel >= 0) if include_diag else (rel > 0)
    decay_in = jnp.where(mask[None], jnp.exp(log_gamma[:, None, None] * jnp.maximum(rel, 0.0)[None]), 0.0)
    decay_q = jnp.exp(log_gamma[:, None] * (idx[None, :] + 1.0))
    decay_k = jnp.exp(log_gamma[:, None] * (CHUNK - 1.0 - idx[None, :]))
    decay_chunk = jnp.exp(log_gamma * CHUNK)

    def chunks(t):
        return t.astype(jnp.float32).reshape(B, n, CHUNK, H, t.shape[-1]).transpose(1, 0, 3, 2, 4)

    def step(state, inp):
        qi, ki, vi = inp
        s = jnp.einsum('bhid,bhjd->bhij', qi, ki) * decay_in[None]
        inner = jnp.einsum('bhij,bhje->bhie', s, vi)
        cross = jnp.einsum('bhid,bhde->bhie', qi, state) * decay_q[None, :, :, None]
        new_state = state * decay_chunk[None, :, None, None] + jnp.einsum(
            'bhjd,bhje->bhde', ki * decay_k[None, :, :, None], vi)
        return new_state, inner + cross

    state0 = jnp.zeros((B, H, dk, dv), jnp.float32)
    _, out = lax.scan(step, state0, (chunks(q), chunks(k), chunks(v)))
    return out.transpose(1, 0, 3, 2, 4).reshape(B, S, H, dv)


def bidirectional_retention(q, k, v, log_gamma_f, log_gamma_b):
    fwd = retention_chunkwise(q, k, v, log_gamma_f, True)
    bwd = retention_chunkwise(q[:, ::-1], k[:, ::-1], v[:, ::-1], log_gamma_b, False)[:, ::-1]
    return fwd + bwd


def head_group_norm(y, w):
    B, S, H, dv = y.shape
    mu = jnp.mean(y, -1, keepdims=True)
    var = jnp.mean(jnp.square(y - mu), -1, keepdims=True)
    return ((y - mu) * lax.rsqrt(var + LN_EPS)).reshape(B, S, H * dv) * w


def latent_attention(c_q, c_kv, k_rope, q_norm_w, w_uq, kv_norm_w, w_ukv):
    B, S, _ = c_q.shape
    q = (rms_norm(c_q, q_norm_w) @ w_uq).reshape(B, S, MLA_HEADS, MLA_QK_DIM)
    q = jnp.concatenate([q[..., :MLA_NOPE_DIM], apply_rotary(q[..., MLA_NOPE_DIM:])], -1) * MLA_SCALE
    kv = (rms_norm(c_kv, kv_norm_w) @ w_ukv).reshape(B, S, MLA_HEADS, MLA_NOPE_DIM + MLA_V_DIM)
    k_nope, v = kv[..., :MLA_NOPE_DIM], kv[..., MLA_NOPE_DIM:]
    k_pe = jnp.broadcast_to(apply_rotary(k_rope[:, :, None, :]), (B, S, MLA_HEADS, MLA_ROPE_DIM))
    k = jnp.concatenate([k_nope, k_pe], -1)
    nq = S // Q_BLOCK
    qb = q.reshape(B, nq, Q_BLOCK, MLA_HEADS, MLA_QK_DIM).transpose(1, 0, 2, 3, 4)

    def attend(q_blk):
        s = jnp.einsum('bqhd,bkhd->bhqk', q_blk, k).astype(jnp.float32)
        p = jax.nn.softmax(s, axis=-1).astype(v.dtype)
        return jnp.einsum('bhqk,bkhd->bqhd', p, v)

    o = lax.map(attend, qb)
    return o.transpose(1, 0, 2, 3, 4).reshape(B, S, MLA_WIDTH)


def encoder_layer(x, c, w_ada, b_ada, w_in, ret_decay_f, ret_decay_b, ret_gn_w,
                  q_norm_w, w_uq, kv_norm_w, w_ukv, w_o, ln1_w, ln1_b,
                  w_up, w_down, ln2_w, ln2_b):
    B, S, _ = x.shape
    mod = (jax.nn.silu(c) @ w_ada + b_ada)[:, None, :]
    sh1, sc1, g1, sh2, sc2, g2 = jnp.split(mod, N_MOD, axis=-1)

    h = layer_norm_plain(x) * (1.0 + sc1) + sh1
    r_q, r_k, r_v, r_g, c_q, c_kv, k_rope = jnp.split(h @ w_in, IN_SPLITS, axis=-1)
    heads = lambda t: t.reshape(B, S, RET_HEADS, RET_HEAD_DIM)
    rq = apply_rotary(heads(r_q))
    rk = apply_rotary(heads(r_k)) * (RET_HEAD_DIM ** -0.5)
    lg_f = jax.nn.log_sigmoid(ret_decay_f.astype(jnp.float32))
    lg_b = jax.nn.log_sigmoid(ret_decay_b.astype(jnp.float32))
    ret = bidirectional_retention(rq, rk, heads(r_v), lg_f, lg_b)
    ret = (jax.nn.silu(r_g) * head_group_norm(ret, ret_gn_w)).astype(x.dtype)
    att = latent_attention(c_q, c_kv, k_rope, q_norm_w, w_uq, kv_norm_w, w_ukv)
    mix = jnp.concatenate([ret, att], -1) @ w_o
    x = layer_norm_affine(DEEPNORM_ALPHA * x + g1 * mix, ln1_w, ln1_b)

    h = layer_norm_plain(x) * (1.0 + sc2) + sh2
    ff = jnp.square(jax.nn.relu(h @ w_up)) @ w_down
    return layer_norm_affine(DEEPNORM_ALPHA * x + g2 * ff, ln2_w, ln2_b)


def encoder_trunk(x, c, w_ada, b_ada, w_in, ret_decay_f, ret_decay_b, ret_gn_w,
                  q_norm_w, w_uq, kv_norm_w, w_ukv, w_o, ln1_w, ln1_b,
                  w_up, w_down, ln2_w, ln2_b):
    for l in range(DEPTH):
        x = encoder_layer(x, c, w_ada[l], b_ada[l], w_in[l], ret_decay_f[l], ret_decay_b[l],
                          ret_gn_w[l], q_norm_w[l], w_uq[l], kv_norm_w[l], w_ukv[l], w_o[l],
                          ln1_w[l], ln1_b[l], w_up[l], w_down[l], ln2_w[l], ln2_b[l])
    return x


def setup_inputs(seed: int = 0) -> dict:
    key = jax.random.key(seed)
    ks = jax.random.split(key, 24)
    nrm = lambda k, shape, s: jax.random.normal(k, shape, jnp.float32) * s
    L = DEPTH
    hidx = jnp.arange(RET_HEADS, dtype=jnp.float32)
    dec_f = jnp.log(2.0 ** (5.0 + hidx) - 1.0)
    dec_b = jnp.log(2.0 ** (5.5 + hidx) - 1.0)
    return {
        "x_prompt": nrm(ks[0], (BATCH, SEQ, D_MODEL), 1.0),
        "x_sample": nrm(ks[1], (DEC_BATCH, DEC_SEQ, D_MODEL), 1.0),
        "c_prompt": nrm(ks[2], (BATCH, D_MODEL), 1.0),
        "c_sample": nrm(ks[3], (DEC_BATCH, D_MODEL), 1.0),
        "w_ada": nrm(ks[4], (L, D_MODEL, N_MOD * D_MODEL), D_MODEL ** -0.5),
        "b_ada": nrm(ks[5], (L, N_MOD * D_MODEL), 0.01),
        "w_in": nrm(ks[6], (L, D_MODEL, D_IN), D_MODEL ** -0.5),
        "ret_decay_f": dec_f + nrm(ks[7], (L, RET_HEADS), 0.01),
        "ret_decay_b": dec_b + nrm(ks[8], (L, RET_HEADS), 0.01),
        "ret_gn_w": 1.0 + nrm(ks[9], (L, RET_WIDTH), 0.01),
        "q_norm_w": 1.0 + nrm(ks[10], (L, Q_LORA), 0.01),
        "w_uq": nrm(ks[11], (L, Q_LORA, MLA_HEADS * MLA_QK_DIM), Q_LORA ** -0.5),
        "kv_norm_w": 1.0 + nrm(ks[12], (L, KV_LORA), 0.01),
        "w_ukv": nrm(ks[13], (L, KV_LORA, MLA_HEADS * (MLA_NOPE_DIM + MLA_V_DIM)), KV_LORA ** -0.5),
        "w_o": nrm(ks[14], (L, D_MIX, D_MODEL), (D_MIX ** -0.5) * DEEPNORM_BETA),
        "ln1_w": 1.0 + nrm(ks[15], (L, D_MODEL), 0.01),
        "ln1_b": nrm(ks[16], (L, D_MODEL), 0.01),
        "w_up": nrm(ks[17], (L, D_MODEL, D_FF), D_MODEL ** -0.5),
        "w_down": nrm(ks[18], (L, D_FF, D_MODEL), (D_FF ** -0.5) * DEEPNORM_BETA),
        "ln2_w": 1.0 + nrm(ks[19], (L, D_MODEL), 0.01),
        "ln2_b": nrm(ks[20], (L, D_MODEL), 0.01),
    }


def reference(x_prompt, x_sample, c_prompt, c_sample, w_ada, b_ada, w_in, ret_decay_f,
              ret_decay_b, ret_gn_w, q_norm_w, w_uq, kv_norm_w, w_ukv, w_o, ln1_w, ln1_b,
              w_up, w_down, ln2_w, ln2_b):
    y_prompt = encoder_trunk(x_prompt, c_prompt, w_ada, b_ada, w_in, ret_decay_f, ret_decay_b,
                             ret_gn_w, q_norm_w, w_uq, kv_norm_w, w_ukv, w_o, ln1_w, ln1_b,
                             w_up, w_down, ln2_w, ln2_b)
    y_sample = encoder_trunk(x_sample, c_sample, w_ada, b_ada, w_in, ret_decay_f, ret_decay_b,
                             ret_gn_w, q_norm_w, w_uq, kv_norm_w, w_ukv, w_o, ln1_w, ln1_b,
                             w_up, w_down, ln2_w, ln2_b)
    return (y_prompt, y_sample)
```

```cpp
#include <hip/hip_runtime.h>
#include <hip/hip_cooperative_groups.h>
#include <cstdio>
#include <cstdint>
namespace cg = cooperative_groups;

#define LAS __attribute__((address_space(3)))
typedef unsigned short bf16_t;
typedef short bf16x8 __attribute__((ext_vector_type(8)));
typedef short s16x4 __attribute__((ext_vector_type(4)));
typedef float f32x4 __attribute__((ext_vector_type(4)));
typedef float f32x16 __attribute__((ext_vector_type(16)));
typedef unsigned u32x4 __attribute__((ext_vector_type(4)));
typedef unsigned u32x2 __attribute__((ext_vector_type(2)));

constexpr int DM = 1024, NTOK = 65536, NIN = 2816, FF = 4096, NMOD = 6144;
constexpr float LN_EPS = 1e-5f, RMS_EPS = 1e-6f;
constexpr float DN_ALPHA = 1.189207115002721f;
constexpr size_t MiB = 1u << 20;
constexpr size_t WS_WIN = 0;
constexpr size_t WS_WUQ = 6 * MiB;
constexpr size_t WS_WUKV = 7 * MiB;
constexpr size_t WS_WO = 8 * MiB;
constexpr size_t WS_WUP = 10 * MiB;
constexpr size_t WS_WDN = 18 * MiB;
constexpr size_t WS_COS64 = 26 * MiB, WS_SIN64 = 30 * MiB;
constexpr size_t WS_COS32 = 34 * MiB, WS_SIN32 = 36 * MiB;
constexpr size_t WS_MOD = 38 * MiB;
constexpr size_t WS_RSTDQ = 38 * MiB + 512 * 1024, WS_RSTDKV = 39 * MiB;
constexpr size_t WS_XN = 40 * MiB;
constexpr size_t WS_R = 168 * MiB;
constexpr size_t WS_Q = 168 * MiB;
constexpr size_t WS_KV = 264 * MiB;
constexpr size_t WS_KPE = 392 * MiB;
constexpr size_t WS_H = 168 * MiB;
constexpr size_t WS_END = 424 * MiB;
constexpr size_t OUT_ST = 0, OUT_CB = 128 * MiB;

__device__ __forceinline__ int tok_seg(int t) { return t < 32768 ? (t >> 14) : 2 + ((t - 32768) >> 13); }
__device__ __forceinline__ int tok_pos(int t) { return t < 32768 ? (t & 16383) : (t & 8191); }
__device__ __forceinline__ unsigned f2bf(float f) { unsigned u = __builtin_bit_cast(unsigned, f); return (u + 0x7fffu + ((u >> 16) & 1u)) >> 16; }
__device__ __forceinline__ unsigned pk2(float lo, float hi) { return f2bf(lo) | (f2bf(hi) << 16); }
__device__ __forceinline__ float bf2f(unsigned short b) { return __builtin_bit_cast(float, (unsigned)b << 16); }
__device__ __forceinline__ float wave_sum(float v) {
#pragma unroll
    for (int o = 1; o < 64; o <<= 1) v += __shfl_xor(v, o);
    return v;
}

namespace pg8 {
constexpr int BM = 256, BK = 64, HALF = 128, HTB = HALF * BK * 2, STAGE_BYTES = 8 * HTB, NXCD = 8, WGM = 8;
__host__ __device__ __forceinline__ int lds_byte(int r, int c) { const int st = (r >> 4) * 2 + (c >> 5), rr = r & 15, cc = c & 31, ob = rr * 64 + cc * 2; return st * 1024 + (ob ^ (((ob >> 9) & 1) << 5)); }
__host__ __device__ __forceinline__ void stage_rc(int b, int& R, int& C) { const int st = b / 1024, sb = b % 1024, swz = sb ^ (((sb >> 9) & 1) << 5); R = (st >> 1) * 16 + swz / 64; C = (st & 1) * 32 + (swz % 64) / 2; }
__host__ __device__ __forceinline__ int perm32(int rho) { const int n = rho >> 4, i = rho & 15; return 8 * (i >> 2) + 4 * n + (i & 3); }
struct Unit { int pm, pn; };
struct Gemm { const bf16_t* A; const bf16_t* Bt; int M, N, K, lda; };
struct StaticOrder {
    int nM, nN, nwg, G, c;
    __host__ __device__ void init(int M, int N, int G_, int c_) { nM = M / BM; nN = N / BM; nwg = nM * nN; G = G_; c = c_; }
    __host__ __device__ bool next(int i, Unit& u) const {
        const long L = (long)i * G + c; if (L >= nwg) return false;
        int wgid = (int)L; { const int q = nwg / NXCD, r = nwg % NXCD, xcd = wgid % NXCD, off = wgid / NXCD; wgid = (xcd < r ? xcd * (q + 1) : r * (q + 1) + (xcd - r) * q) + off; }
        const int nig = WGM * nN, gid = wgid / nig, fm = gid * WGM, gsz = (nM - fm) < WGM ? (nM - fm) : WGM;
        u.pm = fm + ((wgid % nig) % gsz); u.pn = (wgid % nig) / gsz; return true;
    }
};

template <class Epi, bool ALIGN_EPI = true>
__device__ __forceinline__ void gemm_phase(LAS unsigned char* lds, const Gemm g, const StaticOrder& S, const Epi& E) {
    int tid = threadIdx.x; asm volatile("" : "+v"(tid));
    const int wid = __builtin_amdgcn_readfirstlane(tid >> 6), lane = tid & 63, wr = wid >> 2, wc = wid & 3, fr = lane & 15, fq = lane >> 4;
    int K = g.K, lda = g.lda; asm volatile("" : "+s"(K), "+s"(lda));
    const int nt = K / BK;
    unsigned voffA[2], voffB[2];
#pragma unroll
    for (int i = 0; i < 2; ++i) { int R, C; stage_rc(tid * 16 + i * 8192, R, C); const int Rb = Epi::PERM ? ((R & ~31) + perm32(R & 31)) : R;
        voffA[i] = (unsigned)(R * lda + C) * 2u; voffB[i] = (unsigned)(Rb * K + C) * 2u; }
    const size_t kstep = (size_t)(BK * 2);
    const size_t hstepA = (size_t)HALF * lda * 2, hstepB = (size_t)HALF * K * 2;
    const size_t tstepA = 2 * hstepA, tstepB = 2 * hstepB;
    const unsigned ldsw = (unsigned)wid * 1024u;
    const int aoff = lds_byte(wr * 64 + fr, fq * 8), boff = lds_byte(wc * 32 + fr, fq * 8);
#define PG8_SA(b, h) (((b) * 2 + (h)) * HTB)
#define PG8_SB(b, h) ((4 + (b) * 2 + (h)) * HTB)
#define PG8_STAGE(bufoff, gbase, voff) do { _Pragma("unroll") for (int _i = 0; _i < 2; ++_i) \
        __builtin_amdgcn_global_load_lds((const unsigned*)((const char*)(gbase) + (voff)[_i]), (LAS unsigned*)(lds + (bufoff) + ldsw + _i * 8192), 16, 0, 0); } while (0)
#define PG8_LDA(dst, b, h) do { _Pragma("unroll") for (int m = 0; m < 4; ++m) _Pragma("unroll") for (int k = 0; k < 2; ++k) dst[m][k] = *(const LAS bf16x8*)(lds + PG8_SA(b, h) + aoff + m * 2048 + k * 1024); } while (0)
#define PG8_LDB(dst, b, h) do { _Pragma("unroll") for (int n = 0; n < 2; ++n) _Pragma("unroll") for (int k = 0; k < 2; ++k) dst[n][k] = *(const LAS bf16x8*)(lds + PG8_SB(b, h) + boff + n * 2048 + k * 1024); } while (0)
#define PG8_MMA(ai, bj, At, Bt) do { __builtin_amdgcn_s_setprio(1); _Pragma("unroll") for (int m = 0; m < 4; ++m) _Pragma("unroll") for (int n = 0; n < 2; ++n) _Pragma("unroll") for (int k = 0; k < 2; ++k) \
        acc[ai][bj][m][n] = __builtin_amdgcn_mfma_f32_16x16x32_bf16(Bt[n][k], At[m][k], acc[ai][bj][m][n], 0, 0, 0); __builtin_amdgcn_s_setprio(0); } while (0)
#define PG8_WAIT_V(n) asm volatile("s_waitcnt vmcnt(" #n ")" ::: "memory")
#define PG8_WAIT_L(n) asm volatile("s_waitcnt lgkmcnt(" #n ")" ::: "memory")
#define PG8_BAR __builtin_amdgcn_s_barrier()
#define PG8_SCHED __builtin_amdgcn_sched_barrier(0)
    Unit cur, nxt; int ui = 0;
    if (!S.next(0, cur)) return;
    f32x4 acc[2][2][4][2];
#pragma unroll
    for (int a = 0; a < 2; ++a)
#pragma unroll
        for (int b = 0; b < 2; ++b)
#pragma unroll
            for (int m = 0; m < 4; ++m)
#pragma unroll
                for (int n = 0; n < 2; ++n) acc[a][b][m][n] = (f32x4){0.f, 0.f, 0.f, 0.f};
    bf16x8 At[4][2], B0[2][2], B1[2][2];
    const char* cA = (const char*)g.A + (size_t)cur.pm * tstepA; const char* cB = (const char*)g.Bt + (size_t)cur.pn * tstepB;
    PG8_STAGE(PG8_SB(0, 0), cB, voffB); PG8_STAGE(PG8_SB(0, 1), cB + hstepB, voffB); PG8_STAGE(PG8_SA(0, 0), cA, voffA); PG8_STAGE(PG8_SA(0, 1), cA + hstepA, voffA);
    if (wr == 1) PG8_BAR;
    PG8_WAIT_V(2); PG8_BAR;
    PG8_STAGE(PG8_SB(1, 0), cB + kstep, voffB); PG8_STAGE(PG8_SA(1, 0), cA + kstep, voffA); PG8_STAGE(PG8_SB(1, 1), cB + hstepB + kstep, voffB);
    PG8_WAIT_V(6); PG8_BAR;
    for (;;) {
        const bool has_next = S.next(ui + 1, nxt);
        const char* nA = has_next ? (const char*)g.A + (size_t)nxt.pm * tstepA : cA; const char* nB = has_next ? (const char*)g.Bt + (size_t)nxt.pn * tstepB : cB;
        for (int t = 0; t < nt; t += 2) {
            const bool last = (t == nt - 2);
            const char* a1 = cA + (size_t)(t + 1) * kstep;
            const char* a2 = last ? nA : cA + (size_t)(t + 2) * kstep; const char* b2 = last ? nB : cB + (size_t)(t + 2) * kstep;
            const char* a3 = a2 + kstep; const char* b3 = b2 + kstep;
            PG8_LDB(B0, 0, 0); PG8_LDB(B1, 0, 1); PG8_SCHED; PG8_LDA(At, 0, 0); PG8_STAGE(PG8_SA(1, 1), a1 + hstepA, voffA);
            PG8_WAIT_V(8); PG8_WAIT_L(0); PG8_BAR; PG8_MMA(0, 0, At, B0); PG8_MMA(0, 1, At, B1); PG8_BAR; PG8_SCHED;
            PG8_LDA(At, 0, 1); PG8_STAGE(PG8_SB(0, 0), b2, voffB); PG8_STAGE(PG8_SB(0, 1), b2 + hstepB, voffB); PG8_STAGE(PG8_SA(0, 0), a2, voffA);
            PG8_WAIT_V(8); PG8_WAIT_L(0); PG8_BAR; PG8_MMA(1, 0, At, B0); PG8_MMA(1, 1, At, B1); PG8_BAR; PG8_SCHED;
            PG8_LDB(B0, 1, 0); PG8_LDB(B1, 1, 1); PG8_SCHED; PG8_LDA(At, 1, 0); PG8_STAGE(PG8_SA(0, 1), a2 + hstepA, voffA);
            PG8_WAIT_V(8); PG8_WAIT_L(0); PG8_BAR; PG8_MMA(0, 0, At, B0); PG8_MMA(0, 1, At, B1); PG8_BAR; PG8_SCHED;
            PG8_LDA(At, 1, 1); PG8_STAGE(PG8_SB(1, 0), b3, voffB); PG8_STAGE(PG8_SB(1, 1), b3 + hstepB, voffB); PG8_STAGE(PG8_SA(1, 0), a3, voffA);
            PG8_WAIT_V(8); PG8_WAIT_L(0); PG8_BAR; PG8_MMA(1, 0, At, B0); PG8_MMA(1, 1, At, B1); PG8_BAR; PG8_SCHED;
        }
        if constexpr (ALIGN_EPI) { if (wr == 0) PG8_BAR; }
        E(acc, cur, wr, wc, fr, fq);
        if (!has_next) break;
#pragma unroll
        for (int a = 0; a < 2; ++a)
#pragma unroll
            for (int b = 0; b < 2; ++b)
#pragma unroll
                for (int m = 0; m < 4; ++m)
#pragma unroll
                    for (int n = 0; n < 2; ++n) acc[a][b][m][n] = (f32x4){0.f, 0.f, 0.f, 0.f};
        cur = nxt; cA = nA; cB = nB; ++ui;
        if constexpr (ALIGN_EPI) { if (wr == 1) PG8_BAR; }
    }
    PG8_WAIT_V(0);
    if constexpr (!ALIGN_EPI) { if (wr == 0) PG8_BAR; }
    PG8_BAR;
#undef PG8_SA
#undef PG8_SB
#undef PG8_STAGE
#undef PG8_LDA
#undef PG8_LDB
#undef PG8_MMA
#undef PG8_WAIT_V
#undef PG8_WAIT_L
#undef PG8_BAR
#undef PG8_SCHED
}
}
using pg8::Unit;
typedef const f32x4 (&AccRef)[2][2][4][2];

struct EpiRot {
    static constexpr bool PERM = false;
    bf16_t *RQ, *RK; const float *cos64, *sin64;
    __device__ __forceinline__ void operator()(AccRef acc, const Unit& u, int wr, int wc, int fr, int fq) const {
        const int row0 = u.pm * 256 + wr * 64 + fr, pn = u.pn;
        bf16_t* dst = pn < 2 ? RQ : RK; const float sc = pn < 2 ? 1.f : 0.08838834764831845f;
        const int i0 = wc * 16 + fq * 4;
#pragma unroll
        for (int ai = 0; ai < 2; ++ai)
#pragma unroll
            for (int m = 0; m < 4; ++m) { const int t = row0 + ai * 128 + m * 16, pos = tok_pos(t);
                const f32x4 c = *(const f32x4*)(cos64 + (size_t)pos * 64 + i0) * sc, s = *(const f32x4*)(sin64 + (size_t)pos * 64 + i0) * sc;
#pragma unroll
                for (int bj = 0; bj < 2; ++bj) { const f32x4 x1 = acc[ai][bj][m][0], x2 = acc[ai][bj][m][1];
                    const f32x4 o1 = x1 * c - x2 * s, o2 = x1 * s + x2 * c;
                    bf16_t* p = dst + (size_t)t * 512 + (pn & 1) * 256 + bj * 128 + i0;
                    *(u32x2*)p = (u32x2){pk2(o1[0], o1[1]), pk2(o1[2], o1[3])}; *(u32x2*)(p + 64) = (u32x2){pk2(o2[0], o2[1]), pk2(o2[2], o2[3])}; }
                asm volatile("" ::: "memory"); }
    }
};
struct EpiVG {
    static constexpr bool PERM = false;
    bf16_t *RV, *RG;
    __device__ __forceinline__ void operator()(AccRef acc, const Unit& u, int wr, int wc, int fr, int fq) const {
        const int row0 = u.pm * 256 + wr * 64 + fr, pn = u.pn;
        bf16_t* dst = pn < 2 ? RV : RG; const bool act = pn >= 2;
#pragma unroll
        for (int ai = 0; ai < 2; ++ai)
#pragma unroll
            for (int m = 0; m < 4; ++m) { const int t = row0 + ai * 128 + m * 16;
#pragma unroll
                for (int bj = 0; bj < 2; ++bj)
#pragma unroll
                    for (int n = 0; n < 2; ++n) { f32x4 v = acc[ai][bj][m][n];
                        if (act) {
#pragma unroll
                            for (int j = 0; j < 4; ++j) v[j] = v[j] / (1.f + __expf(-v[j])); }
                        bf16_t* p = dst + (size_t)t * 512 + (pn & 1) * 256 + bj * 128 + wc * 32 + n * 16 + fq * 4;
                        *(u32x2*)p = (u32x2){pk2(v[0], v[1]), pk2(v[2], v[3])}; }
                asm volatile("" ::: "memory"); }
    }
};
struct EpiQR {
    static constexpr bool PERM = false;
    bf16_t* Q; const float *cos32, *sin32;
    __device__ __forceinline__ void operator()(AccRef acc, const Unit& u, int wr, int wc, int fr, int fq) const {
        const int row0 = u.pm * 256 + wr * 64 + fr;
        const int i0 = (wc & 1) * 16 + fq * 4;
#pragma unroll
        for (int ai = 0; ai < 2; ++ai)
#pragma unroll
            for (int m = 0; m < 4; ++m) { const int t = row0 + ai * 128 + m * 16; const int pos = tok_pos(t);
                const f32x4 c = *(const f32x4*)(cos32 + (size_t)pos * 32 + i0), s = *(const f32x4*)(sin32 + (size_t)pos * 32 + i0);
#pragma unroll
                for (int bj = 0; bj < 2; ++bj) { const f32x4 x1 = acc[ai][bj][m][0], x2 = acc[ai][bj][m][1];
                    const f32x4 o1 = x1 * c - x2 * s, o2 = x1 * s + x2 * c;
                    bf16_t* p = Q + (size_t)t * 768 + 512 + (2 * bj + (wc >> 1)) * 64 + i0;
                    *(u32x2*)p = (u32x2){pk2(o1[0], o1[1]), pk2(o1[2], o1[3])}; *(u32x2*)(p + 32) = (u32x2){pk2(o2[0], o2[1]), pk2(o2[2], o2[3])}; }
                asm volatile("" ::: "memory"); }
    }
};
template <int ACT  > struct EpiBf16 {
    static constexpr bool PERM = true;
    bf16_t* O; int ldc; const float* rowscale;
    __device__ __forceinline__ void operator()(AccRef acc, const Unit& u, int wr, int wc, int fr, int fq) const {
        const int row0 = u.pm * 256 + wr * 64 + fr, col0 = u.pn * 256 + wc * 32 + 8 * fq;
#pragma unroll
        for (int ai = 0; ai < 2; ++ai)
#pragma unroll
            for (int m = 0; m < 4; ++m) { const int t = row0 + ai * 128 + m * 16; float rs = 1.f; if (ACT == 0) rs = rowscale[t];
                bf16_t* rowp = O + (size_t)t * ldc + col0;
#pragma unroll
                for (int bj = 0; bj < 2; ++bj) { f32x4 v0 = acc[ai][bj][m][0], v1 = acc[ai][bj][m][1];
                    if (ACT == 1) {
#pragma unroll
                        for (int j = 0; j < 4; ++j) { const float a = fmaxf(v0[j], 0.f), b = fmaxf(v1[j], 0.f); v0[j] = a * a; v1[j] = b * b; }
                    } else if (ACT == 0) { v0 = v0 * rs; v1 = v1 * rs; }
                    *(u32x4*)(rowp + bj * 128) = (u32x4){pk2(v0[0], v0[1]), pk2(v0[2], v0[3]), pk2(v1[0], v1[1]), pk2(v1[2], v1[3])}; }
                asm volatile("" ::: "memory"); }
    }
};
struct EpiResid {
    static constexpr bool PERM = false;
    const float *basep, *bases; float* out; const float* gate; int row_base;
    __device__ __forceinline__ void operator()(AccRef acc, const Unit& u, int wr, int wc, int fr, int fq) const {
        const int trow0 = row_base + u.pm * 256; const int seg = tok_seg(trow0);
        const float* base = basep ? (trow0 < 32768 ? basep + (size_t)trow0 * DM : bases + (size_t)(trow0 - 32768) * DM) : out + (size_t)trow0 * DM;
        float* o = out + (size_t)trow0 * DM;
        const int col0 = u.pn * 256 + wc * 32 + 4 * fq;
        f32x4 gv[2][2];
#pragma unroll
        for (int bj = 0; bj < 2; ++bj)
#pragma unroll
            for (int n = 0; n < 2; ++n) gv[bj][n] = *(const f32x4*)(gate + (size_t)seg * NMOD + col0 + bj * 128 + n * 16);
#pragma unroll
        for (int ai = 0; ai < 2; ++ai)
#pragma unroll
            for (int m = 0; m < 4; ++m) { const size_t off = (size_t)(ai * 128 + wr * 64 + m * 16 + fr) * DM + col0;
#pragma unroll
                for (int bj = 0; bj < 2; ++bj)
#pragma unroll
                    for (int n = 0; n < 2; ++n) { const f32x4 b = *(const f32x4*)(base + off + bj * 128 + n * 16);
                        *(f32x4*)(o + off + bj * 128 + n * 16) = b * DN_ALPHA + gv[bj][n] * acc[ai][bj][m][n]; }
                asm volatile("" ::: "memory"); }
    }
};

namespace att {
constexpr int NW = 8, QBLK = 32, KVBLK = 64;
constexpr float SCALE = 0.07216878364870322f;
constexpr float THR = 8.f;
constexpr int LDQ = 768, LDK = 1024, LDR = 64, LDO = 1024;
constexpr int SHM_V = 16384, SHM_K = 16384, SHM_R = 8192;
constexpr int OFF_V = 0, OFF_K = 2 * SHM_V, OFF_R = OFF_K + 2 * SHM_K, OFF_WS = OFF_R + 2 * SHM_R, OFF_QR = OFF_WS + 2048;
#define KSWZ(row, colB) ((row) * 256 + ((colB) ^ (((row) & 7) << 4)))
#define RSWZ(row, ch) ((row) * 128 + ((((ch) ^ ((row) >> 1)) & 7) << 4))
#define SBAR() __builtin_amdgcn_sched_barrier(0)
__device__ __forceinline__ int crow(int r, int hi) { return (r & 3) + 8 * (r >> 2) + 4 * hi; }
__device__ __forceinline__ unsigned cvtpk(float lo, float hi) { unsigned r; asm volatile("v_cvt_pk_bf16_f32 %0, %1, %2" : "=v"(r) : "v"(lo), "v"(hi)); return r; }
__device__ __forceinline__ void partialSM(f32x16& p0, f32x16& p1, float& m_reg, float& mn, float& alpha, const float C, const float thr_raw) {
    float pmax = p0[0];
#pragma unroll
    for (int r = 1; r < 16; ++r) pmax = fmaxf(pmax, p0[r]);
#pragma unroll
    for (int r = 0; r < 16; ++r) pmax = fmaxf(pmax, p1[r]);
    { auto rr = __builtin_amdgcn_permlane32_swap(__float_as_uint(pmax), __float_as_uint(pmax), false, false);
      pmax = fmaxf(__uint_as_float(rr[0]), __uint_as_float(rr[1])); }
    if (__builtin_expect(__all(pmax - m_reg <= thr_raw), 1)) { mn = m_reg; alpha = 1.f; }
    else { mn = fmaxf(m_reg, pmax); alpha = __builtin_amdgcn_exp2f((m_reg - mn) * C); m_reg = mn; }
    const float mnC = -mn * C;
#pragma unroll
    for (int r = 0; r < 16; ++r) p0[r] = fmaf(p0[r], C, mnC);
#pragma unroll
    for (int r = 0; r < 16; ++r) p1[r] = fmaf(p1[r], C, mnC);
#pragma unroll
    for (int r = 0; r < 16; ++r) p0[r] = __builtin_amdgcn_exp2f(p0[r]);
}
__device__ __forceinline__ void finishSM(f32x16& p0, f32x16& p1, float alpha, float& l_reg, bf16x8& pa0, bf16x8& pa1, bf16x8& pa2, bf16x8& pa3) {
#pragma unroll
    for (int r = 0; r < 16; ++r) p1[r] = __builtin_amdgcn_exp2f(p1[r]);
    float ps = 0;
#pragma unroll
    for (int r = 0; r < 16; ++r) ps += p0[r];
#pragma unroll
    for (int r = 0; r < 16; ++r) ps += p1[r];
    { auto rr = __builtin_amdgcn_permlane32_swap(__float_as_uint(ps), __float_as_uint(ps), false, false);
      ps = __uint_as_float(rr[0]) + __uint_as_float(rr[1]); }
    l_reg = l_reg * alpha + ps;
#define PK4(P, BASE, OUT) do { unsigned a0 = cvtpk(P[BASE + 0], P[BASE + 1]), a1 = cvtpk(P[BASE + 2], P[BASE + 3]);   \
    unsigned b0 = cvtpk(P[BASE + 4], P[BASE + 5]), b1 = cvtpk(P[BASE + 6], P[BASE + 7]);                              \
    auto r0 = __builtin_amdgcn_permlane32_swap(a0, b0, false, false); auto r1 = __builtin_amdgcn_permlane32_swap(a1, b1, false, false); \
    u32x4 w = {r0[0], r1[0], r0[1], r1[1]}; OUT = *reinterpret_cast<bf16x8*>(&w); } while (0)
    PK4(p0, 0, pa0); PK4(p0, 8, pa1); PK4(p1, 0, pa2); PK4(p1, 8, pa3);
#undef PK4
}
__device__ __forceinline__ void qkt(f32x16& p0, f32x16& p1, const char* Ks, const char* Rs, const bf16x8* qr, const char* qrl, int r32, int hi) {
    p0 = f32x16{}; p1 = f32x16{};
#pragma unroll
    for (int d0 = 0; d0 < 8; ++d0) { const int cb = (d0 * 16 + hi * 8) * 2;
        const bf16x8 b0 = *reinterpret_cast<const bf16x8*>(Ks + KSWZ(r32, cb));
        const bf16x8 b1 = *reinterpret_cast<const bf16x8*>(Ks + KSWZ(32 + r32, cb));
        p0 = __builtin_amdgcn_mfma_f32_32x32x16_bf16(b0, qr[d0], p0, 0, 0, 0);
        p1 = __builtin_amdgcn_mfma_f32_32x32x16_bf16(b1, qr[d0], p1, 0, 0, 0); }
#pragma unroll
    for (int d1 = 0; d1 < 4; ++d1) { const int ch = d1 * 2 + hi;
        const bf16x8 b0 = *reinterpret_cast<const bf16x8*>(Rs + RSWZ(r32, ch));
        const bf16x8 b1 = *reinterpret_cast<const bf16x8*>(Rs + RSWZ(32 + r32, ch));
        const bf16x8 qf = *reinterpret_cast<const bf16x8*>(qrl + d1 * 1024);
        p0 = __builtin_amdgcn_mfma_f32_32x32x16_bf16(b0, qf, p0, 0, 0, 0);
        p1 = __builtin_amdgcn_mfma_f32_32x32x16_bf16(b1, qf, p1, 0, 0, 0); }
}
__device__ __forceinline__ int v_st(int k, int c) { const int kk = (k & ~0xC) | ((k & 4) << 1) | ((k & 8) >> 1); return ((kk >> 3) * 4 + (c >> 5)) * 512 + ((kk & 7) * 32 + (c & 31)) * 2; }
__device__ __forceinline__ int v_rd_base(int lane) { return ((lane & 3) << 3) | (((lane >> 2) & 3) << 6) | (((lane >> 4) & 1) << 5) | (((lane >> 5) & 1) << 8); }
constexpr int v_rd_off(int d0, int ks, int half) { return d0 * 512 + ks * 4096 + half * 2048; }
template <int OFF> __device__ __forceinline__ s16x4 tr_read(int vb) {
    s16x4 r; asm volatile("ds_read_b64_tr_b16 %0, %1 offset:%2" : "=&v"(r) : "v"(vb), "i"(OFF) : "memory"); return r;
}
template <int D0> __device__ __forceinline__ void pv_one(f32x16& od, int vb, bf16x8 pa0, bf16x8 pa1, bf16x8 pa2, bf16x8 pa3) {
    const s16x4 l0 = tr_read<v_rd_off(D0, 0, 0)>(vb), h0 = tr_read<v_rd_off(D0, 0, 1)>(vb), l1 = tr_read<v_rd_off(D0, 1, 0)>(vb), h1 = tr_read<v_rd_off(D0, 1, 1)>(vb);
    const s16x4 l2 = tr_read<v_rd_off(D0, 2, 0)>(vb), h2 = tr_read<v_rd_off(D0, 2, 1)>(vb), l3 = tr_read<v_rd_off(D0, 3, 0)>(vb), h3 = tr_read<v_rd_off(D0, 3, 1)>(vb);
    asm volatile("s_waitcnt lgkmcnt(0)" ::: "memory"); SBAR();
#define PK(L, H) (bf16x8){L[0], L[1], L[2], L[3], H[0], H[1], H[2], H[3]}
    od = __builtin_amdgcn_mfma_f32_32x32x16_bf16(pa0, PK(l0, h0), od, 0, 0, 0);
    od = __builtin_amdgcn_mfma_f32_32x32x16_bf16(pa1, PK(l1, h1), od, 0, 0, 0);
    od = __builtin_amdgcn_mfma_f32_32x32x16_bf16(pa2, PK(l2, h2), od, 0, 0, 0);
    od = __builtin_amdgcn_mfma_f32_32x32x16_bf16(pa3, PK(l3, h3), od, 0, 0, 0);
#undef PK
}
__device__ __forceinline__ void pv_d0(f32x16* o, int vb, bf16x8 pa0, bf16x8 pa1, bf16x8 pa2, bf16x8 pa3) {
    pv_one<0>(o[0], vb, pa0, pa1, pa2, pa3); pv_one<1>(o[1], vb, pa0, pa1, pa2, pa3); pv_one<2>(o[2], vb, pa0, pa1, pa2, pa3); pv_one<3>(o[3], vb, pa0, pa1, pa2, pa3);
}
__device__ __forceinline__ void attn_unit(const bf16_t* Qn, const bf16_t* Qr, const float* rq, const bf16_t* Kh, const bf16_t* Vh, const bf16_t* Rh, bf16_t* Ob, int seq, char* lds) {
    int tid = threadIdx.x; asm volatile("" : "+v"(tid));
    const int wid = tid >> 6, lane = tid & 63, r32 = lane & 31, hi = lane >> 5;
    char* V_lds = lds + OFF_V; char* K_lds = lds + OFF_K; char* R_lds = lds + OFF_R;
    float* ws = (float*)(lds + OFF_WS) + wid * 64; float* li_l = ws; float* al_l = ws + 32;
    float m_reg = -1e30f, l_reg = 0; f32x16 o[4] = {}; bf16x8 qr[8]; char* qrl = lds + OFF_QR + wid * 4096 + lane * 16;
    const float rqv = rq[wid * QBLK + r32]; const float Cq = SCALE * 1.4426950408889634f * rqv, thr_raw = THR / (SCALE * rqv);
    { const bf16_t* Qw = Qn + (long)(wid * QBLK + r32) * LDQ + hi * 8;
#pragma unroll
      for (int d0 = 0; d0 < 8; ++d0) qr[d0] = *reinterpret_cast<const bf16x8*>(Qw + d0 * 16);
      const bf16_t* Qw2 = Qr + (long)(wid * QBLK + r32) * LDQ + hi * 8;
#pragma unroll
      for (int d0 = 0; d0 < 4; ++d0) *reinterpret_cast<bf16x8*>(qrl + d0 * 1024) = *reinterpret_cast<const bf16x8*>(Qw2 + d0 * 16); }
    const int sr = tid >> 4, sc = (tid & 15) * 8, vst0 = v_st(sr, sc), vst1 = v_st(32 + sr, sc);
    const int rr_ = tid >> 3, rc_ = tid & 7, rst = RSWZ(rr_, rc_);
    const int vb0 = (int)(uintptr_t)V_lds + v_rd_base(lane);
    struct { bf16x8 vs0, vs1, ks0, ks1, rs; } sr_[1];
#define SLOAD(i, k0) do { sr_[i].vs0 = *reinterpret_cast<const bf16x8*>(&Vh[(long)((k0) + sr) * LDK + sc]); sr_[i].vs1 = *reinterpret_cast<const bf16x8*>(&Vh[(long)((k0) + 32 + sr) * LDK + sc]); \
    sr_[i].ks0 = *reinterpret_cast<const bf16x8*>(&Kh[(long)((k0) + sr) * LDK + sc]); sr_[i].ks1 = *reinterpret_cast<const bf16x8*>(&Kh[(long)((k0) + 32 + sr) * LDK + sc]); \
    sr_[i].rs = *reinterpret_cast<const bf16x8*>(&Rh[(long)((k0) + rr_) * LDR + rc_ * 8]); } while (0)
#define SWRITE(b, i) do { *(bf16x8*)(V_lds + (b) * SHM_V + vst0) = sr_[i].vs0; *(bf16x8*)(V_lds + (b) * SHM_V + vst1) = sr_[i].vs1; const int kc = sc * 2; \
    *(bf16x8*)(K_lds + (b) * SHM_K + KSWZ(sr, kc)) = sr_[i].ks0; *(bf16x8*)(K_lds + (b) * SHM_K + KSWZ(32 + sr, kc)) = sr_[i].ks1; \
    *(bf16x8*)(R_lds + (b) * SHM_R + rst) = sr_[i].rs; } while (0)
#define SWAIT() asm volatile("s_waitcnt vmcnt(0)" ::: "memory")
#define RESC(a) do { if (__any((a) < 1.f)) { if (hi == 0) al_l[r32] = (a); asm volatile("s_waitcnt lgkmcnt(0)" ::: "memory"); \
    _Pragma("unroll") for (int d = 0; d < 4; ++d) _Pragma("unroll") for (int r = 0; r < 16; ++r) o[d][r] *= al_l[crow(r, hi)]; } } while (0)
    f32x16 pA0, pA1, pB0, pB1; float mnA, mnB, alA, alB; bf16x8 pa0, pa1, pa2, pa3; const int NT = seq / KVBLK;
    SLOAD(0, 0); SWAIT(); SWRITE(0, 0); __syncthreads();
    qkt(pA0, pA1, K_lds, R_lds, qr, qrl, r32, hi); partialSM(pA0, pA1, m_reg, mnA, alA, Cq, thr_raw);
    SLOAD(0, KVBLK);
    SWAIT(); SWRITE(1, 0); __syncthreads();
    for (int j = 1; j + 1 < NT; j += 2) {
        SBAR(); qkt(pB0, pB1, K_lds + SHM_K, R_lds + SHM_R, qr, qrl, r32, hi);
        finishSM(pA0, pA1, alA, l_reg, pa0, pa1, pa2, pa3); SBAR();
        SLOAD(0, (j + 1) * KVBLK); SBAR();
        pv_d0(o, vb0, pa0, pa1, pa2, pa3); partialSM(pB0, pB1, m_reg, mnB, alB, Cq, thr_raw);
        __syncthreads(); SWAIT(); SWRITE(0, 0);
        RESC(alB); __syncthreads();
        SBAR(); qkt(pA0, pA1, K_lds, R_lds, qr, qrl, r32, hi);
        finishSM(pB0, pB1, alB, l_reg, pa0, pa1, pa2, pa3); SBAR();
        SLOAD(0, (j + 2) * KVBLK); SBAR();
        pv_d0(o, vb0 + SHM_V, pa0, pa1, pa2, pa3); partialSM(pA0, pA1, m_reg, mnA, alA, Cq, thr_raw);
        __syncthreads(); SWAIT(); SWRITE(1, 0);
        RESC(alA); __syncthreads();
    }
    SBAR(); qkt(pB0, pB1, K_lds + SHM_K, R_lds + SHM_R, qr, qrl, r32, hi);
    finishSM(pA0, pA1, alA, l_reg, pa0, pa1, pa2, pa3); SBAR();
    pv_d0(o, vb0, pa0, pa1, pa2, pa3); partialSM(pB0, pB1, m_reg, mnB, alB, Cq, thr_raw);
    __syncthreads(); RESC(alB);
    finishSM(pB0, pB1, alB, l_reg, pa0, pa1, pa2, pa3); SBAR();
    pv_d0(o, vb0 + SHM_V, pa0, pa1, pa2, pa3);
    if (hi == 0) li_l[r32] = l_reg; asm volatile("s_waitcnt lgkmcnt(0)" ::: "memory");
    float rli[16];
#pragma unroll
    for (int r = 0; r < 16; ++r) rli[r] = __builtin_amdgcn_rcpf(li_l[crow(r, hi)]);
    bf16_t* Ow = Ob + (long)(wid * QBLK) * LDO;
#pragma unroll
    for (int r = 0; r < 16; ++r) { const int orow = crow(r, hi);
#pragma unroll
        for (int d0 = 0; d0 < 4; ++d0) Ow[(long)orow * LDO + d0 * 32 + r32] = (bf16_t)f2bf(o[d0][r] * rli[r]); }
    __syncthreads();
#undef SLOAD
#undef SWRITE
#undef SWAIT
#undef RESC
}
#undef SBAR
}

__device__ __forceinline__ int tbyte(int row, int col) { return row * 256 + ((((col >> 3) ^ row) & 15) << 4) + (col & 7) * 2; }
__device__ __forceinline__ bf16x8 lds_frag(const char* base, int row, int col) { return *reinterpret_cast<const bf16x8*>(base + tbyte(row, col)); }
#define MFMA16(a, b, c) __builtin_amdgcn_mfma_f32_16x16x32_bf16(a, b, c, 0, 0, 0)

struct Args {
    const float* in[21]; float* out; unsigned char* ws;
};

__global__ void __launch_bounds__(512) fwd_kernel(Args a) {
    extern __shared__ __attribute__((aligned(16))) unsigned char lds_raw[];
    cg::grid_group grid = cg::this_grid();
    char* lds = (char*)lds_raw;
    LAS unsigned char* lds3 = (LAS unsigned char*)lds_raw;
    const int tid = threadIdx.x, lane = tid & 63, wave = tid >> 6;
    const int G = gridDim.x, bx = blockIdx.x;
    const int gw = bx * 8 + wave, NGW = G * 8;
    unsigned char* ws = a.ws;
    const float *x_prompt = a.in[0], *x_sample = a.in[1], *c_prompt = a.in[2], *c_sample = a.in[3], *w_ada = a.in[4], *b_ada = a.in[5], *w_in = a.in[6],
                *ret_decay_f = a.in[7], *ret_decay_b = a.in[8], *ret_gn_w = a.in[9], *q_norm_w = a.in[10], *w_uq = a.in[11], *kv_norm_w = a.in[12], *w_ukv = a.in[13],
                *w_o = a.in[14], *ln1_w = a.in[15], *ln1_b = a.in[16], *w_up = a.in[17], *w_down = a.in[18], *ln2_w = a.in[19], *ln2_b = a.in[20];
    float* out = a.out;
    bf16_t *WinT = (bf16_t*)(ws + WS_WIN), *WuqT = (bf16_t*)(ws + WS_WUQ), *WukvT = (bf16_t*)(ws + WS_WUKV), *WoT = (bf16_t*)(ws + WS_WO), *WupT = (bf16_t*)(ws + WS_WUP), *WdnT = (bf16_t*)(ws + WS_WDN);
    float *cos64 = (float*)(ws + WS_COS64), *sin64 = (float*)(ws + WS_SIN64), *cos32 = (float*)(ws + WS_COS32), *sin32 = (float*)(ws + WS_SIN32);
    float *mod = (float*)(ws + WS_MOD), *rstdq = (float*)(ws + WS_RSTDQ), *rstdkv = (float*)(ws + WS_RSTDKV);
    bf16_t *XN = (bf16_t*)(ws + WS_XN), *MIX = XN;
    bf16_t *RQ = (bf16_t*)(ws + WS_R), *RK = RQ + (size_t)NTOK * 512, *RV = RK + (size_t)NTOK * 512, *RG = RV + (size_t)NTOK * 512;
    bf16_t *Qb = (bf16_t*)(ws + WS_Q), *KVb = (bf16_t*)(ws + WS_KV), *KPE = (bf16_t*)(ws + WS_KPE), *Hb = (bf16_t*)(ws + WS_H);
    bf16_t *ST = (bf16_t*)((unsigned char*)out + OUT_ST), *CB = (bf16_t*)((unsigned char*)out + OUT_CB);

    {
        float* scl = (float*)lds; float* part = (float*)(lds + 24576);
        for (int u = bx; u < 96; u += G) {
            for (int i = tid; i < 6144; i += 512) { const int b = i >> 10, k = i & 1023; const float c = b < 2 ? c_prompt[b * 1024 + k] : c_sample[(b - 2) * 1024 + k]; scl[i] = c / (1.f + __expf(-c)); }
            __syncthreads();
            const int col = u * 64 + lane; float acc[6] = {0.f, 0.f, 0.f, 0.f, 0.f, 0.f};
#pragma unroll 8
            for (int k = wave * 128; k < wave * 128 + 128; ++k) { const float w = w_ada[(size_t)k * NMOD + col];
#pragma unroll
                for (int b = 0; b < 6; ++b) acc[b] += scl[b * 1024 + k] * w; }
#pragma unroll
            for (int b = 0; b < 6; ++b) part[(wave * 6 + b) * 64 + lane] = acc[b];
            __syncthreads();
            if (tid < 384) { const int b = tid >> 6, l = tid & 63; float s = b_ada[u * 64 + l];
#pragma unroll
                for (int w = 0; w < 8; ++w) s += part[(w * 6 + b) * 64 + l];
                mod[b * NMOD + u * 64 + l] = s; }
            __syncthreads();
        }
        float* scr = (float*)(lds + wave * 16384);
        constexpr int I_IN = 16 * 88, I_UQ = 6 * 24, I_UKV = 4 * 32, I_O = 16 * 32, I_UP = 16 * 128, I_DN = 64 * 32;
        constexpr int NITEMS = I_IN + I_UQ + I_UKV + I_O + I_UP + I_DN;
        for (int it = gw; it < NITEMS; it += NGW) {
            int r = it, which; const float* W; const float* kscale = nullptr; bf16_t* WT; int K, ldw, ndest;
            if (r < I_IN) { which = 0; W = w_in; WT = WinT; K = 1024; ldw = 2752; ndest = 2816; }
            else if ((r -= I_IN) < I_UQ) { which = 1; W = w_uq; WT = WuqT; K = 384; ldw = 768; ndest = 768; kscale = q_norm_w; }
            else if ((r -= I_UQ) < I_UKV) { which = 2; W = w_ukv; WT = WukvT; K = 256; ldw = 1024; ndest = 1024; kscale = kv_norm_w; }
            else if ((r -= I_UKV) < I_O) { which = 2; W = w_o; WT = WoT; K = 1024; ldw = 1024; ndest = 1024; }
            else if ((r -= I_O) < I_UP) { which = 2; W = w_up; WT = WupT; K = 1024; ldw = 4096; ndest = 4096; }
            else { r -= I_UP; which = 2; W = w_down; WT = WdnT; K = 4096; ldw = 1024; ndest = 1024; }
            const int nblk = ndest / 32, kb = r / nblk, nb = r % nblk, k0 = 64 * kb, n0 = 32 * nb;
            const int nd = n0 + (lane & 31); int src;
            if (which == 0) { if (nd < 1024) { const int p = nd & 127; src = (nd & ~127) + (p >> 5) * 16 + (p & 15) + 64 * ((p >> 4) & 1); } else src = nd < 2752 ? nd : -1; }
            else if (which == 1) { if (nd < 512) src = (nd >> 7) * 192 + (nd & 127); else { const int q = nd - 512, bj = q >> 7, p = q & 127, wc = p >> 5, n = (p >> 4) & 1, rr = p & 15; src = (2 * bj + (wc >> 1)) * 192 + 128 + (wc & 1) * 16 + rr + 32 * n; } }
            else src = nd;
#pragma unroll 8
            for (int i = 0; i < 32; ++i) { const int kk = 2 * i + (lane >> 5); float v = 0.f;
                if (src >= 0) { v = W[(size_t)(k0 + kk) * ldw + src]; if (kscale) v *= kscale[k0 + kk]; }
                scr[kk * 33 + (lane & 31)] = v; }
            asm volatile("s_waitcnt lgkmcnt(0)" ::: "memory");
            const int c = lane & 7;
#pragma unroll
            for (int j = 0; j < 4; ++j) { const int n = (lane >> 3) + 8 * j; const float* s = scr + (8 * c) * 33 + n;
                u32x4 o; o.x = pk2(s[0 * 33], s[1 * 33]); o.y = pk2(s[2 * 33], s[3 * 33]); o.z = pk2(s[4 * 33], s[5 * 33]); o.w = pk2(s[6 * 33], s[7 * 33]);
                *(u32x4*)(WT + (size_t)(n0 + n) * K + k0 + 8 * c) = o; }
            asm volatile("s_waitcnt lgkmcnt(0)" ::: "memory");
        }
        for (int i = bx * 512 + tid; i < 16384 * 96; i += G * 512) {
            int pos, fi; float inv; float *cp, *sp;
            if (i < 16384 * 64) { pos = i >> 6; fi = i & 63; inv = exp2f(-(float)fi * (13.287712379549449f / 64.f)); cp = cos64 + i; sp = sin64 + i; }
            else { const int j = i - 16384 * 64; pos = j >> 5; fi = j & 31; inv = exp2f(-(float)fi * (13.287712379549449f / 32.f)); cp = cos32 + j; sp = sin32 + j; }
            const float ang = (float)pos * inv;
            double rev = (double)ang * 0.15915494309189535; rev -= rint(rev);
            const float rf = (float)rev;
            *cp = __builtin_amdgcn_cosf(rf); *sp = __builtin_amdgcn_sinf(rf);
        }
    }
    grid.sync();

    for (int m = gw; m < NTOK; m += NGW) {
        const float* xrow = m < 32768 ? x_prompt + (size_t)m * DM : x_sample + (size_t)(m - 32768) * DM;
        const float* md = mod + (size_t)tok_seg(m) * NMOD;
        const f32x4* xr = (const f32x4*)xrow + lane;
        f32x4 v[4]; float s = 0.f;
#pragma unroll
        for (int j = 0; j < 4; ++j) { v[j] = xr[64 * j]; s += (v[j].x + v[j].y) + (v[j].z + v[j].w); }
        const float mean = wave_sum(s) * (1.f / DM); float s2 = 0.f;
#pragma unroll
        for (int j = 0; j < 4; ++j) { v[j] = v[j] - mean; s2 += (v[j].x * v[j].x + v[j].y * v[j].y) + (v[j].z * v[j].z + v[j].w * v[j].w); }
        const float rstd = 1.f / sqrtf(wave_sum(s2) * (1.f / DM) + LN_EPS);
        u32x2* o8 = (u32x2*)(XN + (size_t)m * DM) + lane;
#pragma unroll
        for (int j = 0; j < 4; ++j) { const int c = 4 * lane + 256 * j; const f32x4 sh = *(const f32x4*)(md + c), sc = *(const f32x4*)(md + 1024 + c);
            const f32x4 h = v[j] * rstd * (sc + 1.f) + sh; o8[64 * j] = (u32x2){pk2(h.x, h.y), pk2(h.z, h.w)}; }
    }
    grid.sync();

    {
        pg8::Gemm g{XN, WinT, NTOK, 1024, DM, DM}; pg8::StaticOrder S; S.init(NTOK, 1024, G, bx);
        EpiRot E{RQ, RK, cos64, sin64};
        pg8::gemm_phase<EpiRot>(lds3, g, S, E);
    }
    {
        pg8::Gemm g{XN, WinT + (size_t)1024 * DM, NTOK, 1024, DM, DM}; pg8::StaticOrder S; S.init(NTOK, 1024, G, bx);
        EpiVG E{RV, RG};
        pg8::gemm_phase<EpiVG>(lds3, g, S, E);
    }
    {
        pg8::Gemm g{XN, WinT + (size_t)2048 * DM, NTOK, 768, DM, DM}; pg8::StaticOrder S; S.init(NTOK, 768, G, bx);
        EpiBf16<2> E{CB, 768, nullptr};
        pg8::gemm_phase<EpiBf16<2>>(lds3, g, S, E);
    }
    grid.sync();

    {
        char *KtF = lds, *KtB = lds + 32768, *Vt = lds + 65536;
        const int fr = lane & 15, fq = lane >> 4;
        for (int unit = bx; unit < 2048; unit += G) {
            const int c = unit >> 2, h = unit & 3; const size_t tok0 = (size_t)c * 128;
            const float l2f = -log2f(1.f + __expf(-ret_decay_f[h])), l2b = -log2f(1.f + __expf(-ret_decay_b[h]));
#pragma unroll
            for (int i = 0; i < 4; ++i) { const int p = tid + 512 * i, dch = p & 15, m = p >> 4;
                const bf16x8 kr = *reinterpret_cast<const bf16x8*>(RK + (tok0 + m) * 512 + h * 128 + dch * 8);
                const bf16x8 vr = *reinterpret_cast<const bf16x8*>(RV + (tok0 + m) * 512 + h * 128 + dch * 8);
                const float df = exp2f(l2f * (float)(127 - m)), db = exp2f(l2b * (float)m);
#pragma unroll
                for (int j = 0; j < 8; ++j) { const int d = dch * 8 + j; const float kf = bf2f((unsigned short)kr[j]);
                    *(bf16_t*)(KtF + tbyte(d, m)) = (bf16_t)f2bf(kf * df); *(bf16_t*)(KtB + tbyte(d, m)) = (bf16_t)f2bf(kf * db); *(bf16_t*)(Vt + tbyte(d, m)) = (bf16_t)vr[j]; } }
            __syncthreads();
            f32x4 af[8], ab[8];
#pragma unroll
            for (int n = 0; n < 8; ++n) { af[n] = (f32x4){0.f, 0.f, 0.f, 0.f}; ab[n] = (f32x4){0.f, 0.f, 0.f, 0.f}; }
#pragma unroll
            for (int ks = 0; ks < 4; ++ks) { const bf16x8 a_f = lds_frag(KtF, 16 * wave + fr, 32 * ks + 8 * fq), a_b = lds_frag(KtB, 16 * wave + fr, 32 * ks + 8 * fq);
#pragma unroll
                for (int n = 0; n < 8; ++n) { const bf16x8 b = lds_frag(Vt, 16 * n + fr, 32 * ks + 8 * fq); af[n] = MFMA16(a_f, b, af[n]); ab[n] = MFMA16(a_b, b, ab[n]); } }
            bf16_t* stf = ST + (size_t)(unit * 2) * 16384; bf16_t* stb = stf + 16384;
#pragma unroll
            for (int n = 0; n < 8; ++n) { const int e = 16 * n + fr, d = 16 * wave + 4 * fq;
                *(u32x2*)(stf + e * 128 + d) = (u32x2){pk2(af[n][0], af[n][1]), pk2(af[n][2], af[n][3])};
                *(u32x2*)(stb + e * 128 + d) = (u32x2){pk2(ab[n][0], ab[n][1]), pk2(ab[n][2], ab[n][3])}; }
            __syncthreads();
        }
    }
    grid.sync();

    for (int w = bx * 512 + tid; w < 48 * 8192; w += G * 512) {
        const int q = w >> 13, e2 = w & 8191, seg = q >> 3, h = (q >> 1) & 3, dir = q & 1;
        const int nch = seg < 2 ? 128 : 64, ch0 = seg < 2 ? seg * 128 : 256 + (seg - 2) * 64;
        const float lg2 = -log2f(1.f + __expf(-(dir ? ret_decay_b[h] : ret_decay_f[h]))); const float dec = exp2f(lg2 * 128.f);
        unsigned* base = (unsigned*)ST + ((size_t)(ch0 * 4 + h) * 2 + dir) * 8192 + e2;
        const long stride = dir ? -(long)(4 * 2 * 8192) : (long)(4 * 2 * 8192);
        unsigned* p = dir ? base + (size_t)(nch - 1) * (4 * 2 * 8192) : base;
        float s0 = 0.f, s1 = 0.f;
        for (int i = 0; i < nch; i += 4) {
            unsigned kv[4];
#pragma unroll
            for (int j = 0; j < 4; ++j) kv[j] = p[j * stride];
#pragma unroll
            for (int j = 0; j < 4; ++j) { p[j * stride] = pk2(s0, s1); s0 = s0 * dec + bf2f((unsigned short)(kv[j] & 0xffffu)); s1 = s1 * dec + bf2f((unsigned short)(kv[j] >> 16)); }
            p += 4 * stride;
        }
    }
    grid.sync();

    {
        char *Qs = lds, *Ks = lds + 32768, *Vt = lds + 65536, *Ps = lds + 98304;
        int tid_l = threadIdx.x; asm volatile("" : "+v"(tid_l));
        const int tid = tid_l, lane = tid & 63, wave = tid >> 6;
        const int fr = lane & 15, fq = lane >> 4;
        for (int unit = bx; unit < 2048; unit += G) {
            const int c = unit >> 2, h = unit & 3; const size_t tok0 = (size_t)c * 128;
            const float l2f = -log2f(1.f + __expf(-ret_decay_f[h])), l2b = -log2f(1.f + __expf(-ret_decay_b[h]));
#pragma unroll
            for (int i = 0; i < 4; ++i) { const int p = tid + 512 * i, ch = p & 15, r = p >> 4;
                const size_t go = (tok0 + r) * 512 + h * 128 + ch * 8;
                *(bf16x8*)(Qs + tbyte(r, ch * 8)) = *reinterpret_cast<const bf16x8*>(RQ + go);
                *(bf16x8*)(Ks + tbyte(r, ch * 8)) = *reinterpret_cast<const bf16x8*>(RK + go);
                const bf16x8 vr = *reinterpret_cast<const bf16x8*>(RV + go);
#pragma unroll
                for (int j = 0; j < 8; ++j) *(bf16_t*)(Vt + tbyte(ch * 8 + j, r)) = (bf16_t)vr[j]; }
            __syncthreads();
            bf16x8 aq[4];
#pragma unroll
            for (int ks = 0; ks < 4; ++ks) aq[ks] = lds_frag(Qs, 16 * wave + fr, 32 * ks + 8 * fq);
#pragma unroll 1
            for (int jm = 0; jm < 8; ++jm) { f32x4 s = (f32x4){0.f, 0.f, 0.f, 0.f};
#pragma unroll
                for (int ks = 0; ks < 4; ++ks) s = MFMA16(aq[ks], lds_frag(Ks, 16 * jm + fr, 32 * ks + 8 * fq), s);
                const int ml = 16 * jm + fr;
#pragma unroll
                for (int r = 0; r < 4; ++r) { const int nl = 16 * wave + 4 * fq + r, diff = nl - ml;
                    const float dv = diff >= 0 ? exp2f(l2f * (float)diff) : exp2f(l2b * (float)(-diff));
                    *(bf16_t*)(Ps + tbyte(nl, ml)) = (bf16_t)f2bf(s[r] * dv); } }
            asm volatile("s_waitcnt lgkmcnt(0)" ::: "memory");
            f32x4 o[8];
#pragma unroll
            for (int je = 0; je < 8; ++je) o[je] = (f32x4){0.f, 0.f, 0.f, 0.f};
#pragma unroll
            for (int ks = 0; ks < 4; ++ks) { const bf16x8 ap = lds_frag(Ps, 16 * wave + fr, 32 * ks + 8 * fq);
#pragma unroll
                for (int je = 0; je < 8; ++je) o[je] = MFMA16(ap, lds_frag(Vt, 16 * je + fr, 32 * ks + 8 * fq), o[je]);
                asm volatile("" ::: "memory"); }
            __syncthreads();
            { const bf16_t* stf = ST + (size_t)(unit * 2) * 16384; const bf16_t* stb = stf + 16384;
#pragma unroll
              for (int i = 0; i < 4; ++i) { const int p = tid + 512 * i, ch = p & 15, r = p >> 4;
                  *(bf16x8*)(Qs + tbyte(r, ch * 8)) = *reinterpret_cast<const bf16x8*>(stf + r * 128 + ch * 8);
                  *(bf16x8*)(Ks + tbyte(r, ch * 8)) = *reinterpret_cast<const bf16x8*>(stb + r * 128 + ch * 8); } }
            __syncthreads();
            float dqf[4], dqb[4];
#pragma unroll
            for (int r = 0; r < 4; ++r) { const int nl = 16 * wave + 4 * fq + r; dqf[r] = exp2f(l2f * (float)(nl + 1)); dqb[r] = exp2f(l2b * (float)(128 - nl)); }
#pragma unroll
            for (int je = 0; je < 8; ++je) { f32x4 xf = (f32x4){0.f, 0.f, 0.f, 0.f}, xb = (f32x4){0.f, 0.f, 0.f, 0.f};
#pragma unroll
                for (int ks = 0; ks < 4; ++ks) { xf = MFMA16(aq[ks], lds_frag(Qs, 16 * je + fr, 32 * ks + 8 * fq), xf); xb = MFMA16(aq[ks], lds_frag(Ks, 16 * je + fr, 32 * ks + 8 * fq), xb); }
#pragma unroll
                for (int r = 0; r < 4; ++r) o[je][r] += dqf[r] * xf[r] + dqb[r] * xb[r];
                asm volatile("" ::: "memory"); }
#pragma unroll
            for (int r = 0; r < 4; ++r) { float s = 0.f;
#pragma unroll
                for (int je = 0; je < 8; ++je) s += o[je][r];
                s += __shfl_xor(s, 1); s += __shfl_xor(s, 2); s += __shfl_xor(s, 4); s += __shfl_xor(s, 8);
                const float mean = s * (1.f / 128.f); float q = 0.f;
#pragma unroll
                for (int je = 0; je < 8; ++je) { const float d = o[je][r] - mean; q += d * d; }
                q += __shfl_xor(q, 1); q += __shfl_xor(q, 2); q += __shfl_xor(q, 4); q += __shfl_xor(q, 8);
                const float rstd = 1.f / sqrtf(q * (1.f / 128.f) + LN_EPS);
                const size_t t = tok0 + 16 * wave + 4 * fq + r;
#pragma unroll
                for (int je = 0; je < 8; ++je) { const int e = 16 * je + fr; const float gt = bf2f(RG[t * 512 + h * 128 + e]);
                    MIX[t * 1024 + h * 128 + e] = (bf16_t)f2bf((o[je][r] - mean) * rstd * ret_gn_w[h * 128 + e] * gt); } }
            __syncthreads();
        }
    }
    grid.sync();

    for (int m = gw; m < NTOK; m += NGW) {
        const bf16_t* row = CB + (size_t)m * 768;
        float sq = 0.f, skv = 0.f;
        if (lane < 48) { const bf16x8 v = *reinterpret_cast<const bf16x8*>(row + lane * 8);
#pragma unroll
            for (int j = 0; j < 8; ++j) { const float f = bf2f((unsigned short)v[j]); sq += f * f; } }
        if (lane < 32) { const bf16x8 v = *reinterpret_cast<const bf16x8*>(row + 384 + lane * 8);
#pragma unroll
            for (int j = 0; j < 8; ++j) { const float f = bf2f((unsigned short)v[j]); skv += f * f; } }
        sq = wave_sum(sq); skv = wave_sum(skv);
        if (lane == 0) { rstdq[m] = 1.f / sqrtf(sq * (1.f / 384.f) + RMS_EPS); rstdkv[m] = 1.f / sqrtf(skv * (1.f / 256.f) + RMS_EPS); }
        if (lane < 32) { const int pos = tok_pos(m); const float x1 = bf2f(row[640 + lane]), x2 = bf2f(row[672 + lane]);
            const float c = cos32[(size_t)pos * 32 + lane], s = sin32[(size_t)pos * 32 + lane];
            KPE[(size_t)m * 64 + lane] = (bf16_t)f2bf(x1 * c - x2 * s); KPE[(size_t)m * 64 + 32 + lane] = (bf16_t)f2bf(x1 * s + x2 * c); }
    }
    grid.sync();

    {
        pg8::Gemm g{CB, WuqT, NTOK, 512, 384, 768}; pg8::StaticOrder S; S.init(NTOK, 512, G, bx);
        EpiBf16<2> E{Qb, 768, nullptr};
        pg8::gemm_phase<EpiBf16<2>>(lds3, g, S, E);
    }
    {
        pg8::Gemm g{CB, WuqT + (size_t)512 * 384, NTOK, 256, 384, 768}; pg8::StaticOrder S; S.init(NTOK, 256, G, bx);
        EpiQR E{Qb, cos32, sin32};
        pg8::gemm_phase<EpiQR>(lds3, g, S, E);
    }
    {
        pg8::Gemm g{CB + 384, WukvT, NTOK, 1024, 256, 768}; pg8::StaticOrder S; S.init(NTOK, 1024, G, bx);
        EpiBf16<0> E{KVb, 1024, rstdkv};
        pg8::gemm_phase<EpiBf16<0>>(lds3, g, S, E);
    }
    grid.sync();

    {
        const int vcu = (G == 256) ? (bx & 7) * 32 + (bx >> 3) : bx;
        for (int U = vcu; U < 1024; U += G) {
            const int round = U >> 8, v = U & 255; int seg, h, qb, seq; size_t tok0;
            if (round < 2) { const int pair = v >> 5; seg = pair >> 2; h = pair & 3; qb = (v & 31) + 32 * round; seq = 16384; tok0 = (size_t)seg * 16384; }
            else { const int pair = (v >> 5) + 8 * (round - 2); seg = 2 + (pair >> 2); h = pair & 3; qb = v & 31; seq = 8192; tok0 = 32768 + (size_t)(seg - 2) * 8192; }
            const size_t q0 = tok0 + (size_t)qb * 256;
            att::attn_unit(Qb + q0 * 768 + h * 128, Qb + q0 * 768 + 512 + h * 64, rstdq + q0, KVb + tok0 * 1024 + h * 256, KVb + tok0 * 1024 + h * 256 + 128, KPE + tok0 * 64,
                           MIX + q0 * 1024 + 512 + h * 128, seq, lds);
        }
    }
    grid.sync();

    {
        pg8::Gemm g{MIX, WoT, NTOK, DM, DM, DM}; pg8::StaticOrder S; S.init(NTOK, DM, G, bx);
        EpiResid E{x_prompt, x_sample, out, mod + 2 * 1024, 0};
        pg8::gemm_phase<EpiResid>(lds3, g, S, E);
    }
    grid.sync();

    for (int m = gw; m < NTOK; m += NGW) {
        const float* md = mod + (size_t)tok_seg(m) * NMOD;
        f32x4* yr = (f32x4*)(out + (size_t)m * DM) + lane;
        f32x4 v[4]; float s = 0.f;
#pragma unroll
        for (int j = 0; j < 4; ++j) { v[j] = yr[64 * j]; s += (v[j].x + v[j].y) + (v[j].z + v[j].w); }
        float mean = wave_sum(s) * (1.f / DM); float s2 = 0.f;
#pragma unroll
        for (int j = 0; j < 4; ++j) { v[j] = v[j] - mean; s2 += (v[j].x * v[j].x + v[j].y * v[j].y) + (v[j].z * v[j].z + v[j].w * v[j].w); }
        float rstd = 1.f / sqrtf(wave_sum(s2) * (1.f / DM) + LN_EPS);
        s = 0.f;
#pragma unroll
        for (int j = 0; j < 4; ++j) { const int c = 4 * lane + 256 * j; v[j] = v[j] * rstd * *(const f32x4*)(ln1_w + c) + *(const f32x4*)(ln1_b + c); yr[64 * j] = v[j]; s += (v[j].x + v[j].y) + (v[j].z + v[j].w); }
        mean = wave_sum(s) * (1.f / DM); s2 = 0.f;
#pragma unroll
        for (int j = 0; j < 4; ++j) { v[j] = v[j] - mean; s2 += (v[j].x * v[j].x + v[j].y * v[j].y) + (v[j].z * v[j].z + v[j].w * v[j].w); }
        rstd = 1.f / sqrtf(wave_sum(s2) * (1.f / DM) + LN_EPS);
        u32x2* o8 = (u32x2*)(XN + (size_t)m * DM) + lane;
#pragma unroll
        for (int j = 0; j < 4; ++j) { const int c = 4 * lane + 256 * j; const f32x4 sh = *(const f32x4*)(md + 3072 + c), sc = *(const f32x4*)(md + 4096 + c);
            const f32x4 h = v[j] * rstd * (sc + 1.f) + sh; o8[64 * j] = (u32x2){pk2(h.x, h.y), pk2(h.z, h.w)}; }
    }
    grid.sync();

    for (int slab = 0; slab < 4; ++slab) {
        const int r0 = slab * 16384;
        {
            pg8::Gemm g{XN + (size_t)r0 * DM, WupT, 16384, FF, DM, DM}; pg8::StaticOrder S; S.init(16384, FF, G, bx);
            EpiBf16<1> E{Hb, FF, nullptr};
            pg8::gemm_phase<EpiBf16<1>>(lds3, g, S, E);
        }
        grid.sync();
        {
            pg8::Gemm g{Hb, WdnT, 16384, DM, FF, FF}; pg8::StaticOrder S; S.init(16384, DM, G, bx);
            EpiResid E{nullptr, nullptr, out, mod + 5 * 1024, r0};
            pg8::gemm_phase<EpiResid>(lds3, g, S, E);
        }
        grid.sync();
    }

    for (int m = gw; m < NTOK; m += NGW) {
        f32x4* yr = (f32x4*)(out + (size_t)m * DM) + lane;
        f32x4 v[4]; float s = 0.f;
#pragma unroll
        for (int j = 0; j < 4; ++j) { v[j] = yr[64 * j]; s += (v[j].x + v[j].y) + (v[j].z + v[j].w); }
        const float mean = wave_sum(s) * (1.f / DM); float s2 = 0.f;
#pragma unroll
        for (int j = 0; j < 4; ++j) { v[j] = v[j] - mean; s2 += (v[j].x * v[j].x + v[j].y * v[j].y) + (v[j].z * v[j].z + v[j].w * v[j].w); }
        const float rstd = 1.f / sqrtf(wave_sum(s2) * (1.f / DM) + LN_EPS);
#pragma unroll
        for (int j = 0; j < 4; ++j) { const int c = 4 * lane + 256 * j; yr[64 * j] = v[j] * rstd * *(const f32x4*)(ln2_w + c) + *(const f32x4*)(ln2_b + c); }
    }
}

extern "C" void kernel_launch(void* const* d_in, const int* in_sizes, int n_in, void* d_out, int out_size, void* d_ws, size_t ws_size, hipStream_t stream) {
    constexpr int LDS_BYTES = 147456;
    static int grid = 0;
    if (grid == 0) {
        if (n_in != 21 || out_size != NTOK * DM || ws_size < WS_END) { fprintf(stderr, "kernel_launch: unexpected shapes (n_in %d out %d ws %zu)\n", n_in, out_size, ws_size); grid = -1; return; }
        int dev = 0, cus = 0, per_cu = 0;
        (void)hipGetDevice(&dev);
        (void)hipDeviceGetAttribute(&cus, hipDeviceAttributeMultiprocessorCount, dev);
        (void)hipFuncSetAttribute((const void*)fwd_kernel, hipFuncAttributeMaxDynamicSharedMemorySize, LDS_BYTES);
        (void)hipOccupancyMaxActiveBlocksPerMultiprocessor(&per_cu, (const void*)fwd_kernel, 512, LDS_BYTES);
        if (per_cu < 1) per_cu = 1;
        grid = cus * per_cu;
    }
    if (grid < 0) return;
    Args a{};
    for (int i = 0; i < 21; ++i) a.in[i] = (const float*)d_in[i];
    a.out = (float*)d_out; a.ws = (unsigned char*)d_ws;
    void* args[] = {&a};
    hipError_t e = hipLaunchCooperativeKernel((const void*)fwd_kernel, dim3(grid), dim3(512), args, LDS_BYTES, stream);
    if (e != hipSuccess) fprintf(stderr, "cooperative launch failed: %s (grid %d)\n", hipGetErrorString(e), grid);
}
```

```cpp
#include <hip/hip_runtime.h>
#include <hip/hip_cooperative_groups.h>
#include <cstdio>
#include <cstdint>
namespace cg = cooperative_groups;

#define LAS __attribute__((address_space(3)))
typedef unsigned short bf16_t;
typedef short bf16x8 __attribute__((ext_vector_type(8)));
typedef short s16x4 __attribute__((ext_vector_type(4)));
typedef float f32x4 __attribute__((ext_vector_type(4)));
typedef float f32x16 __attribute__((ext_vector_type(16)));
typedef unsigned u32x4 __attribute__((ext_vector_type(4)));
typedef unsigned u32x2 __attribute__((ext_vector_type(2)));

constexpr int DM = 1024, NTOK = 65536, NIN = 2816, FF = 4096, NMOD = 6144;
constexpr float LN_EPS = 1e-5f, RMS_EPS = 1e-6f;
constexpr float DN_ALPHA = 1.189207115002721f;
constexpr size_t MiB = 1u << 20;
constexpr size_t WS_WIN = 0;
constexpr size_t WS_WUQ = 6 * MiB;
constexpr size_t WS_WUKV = 7 * MiB;
constexpr size_t WS_WO = 8 * MiB;
constexpr size_t WS_WUP = 10 * MiB;
constexpr size_t WS_WDN = 18 * MiB;
constexpr size_t WS_COS64 = 26 * MiB, WS_SIN64 = 30 * MiB;
constexpr size_t WS_COS32 = 34 * MiB, WS_SIN32 = 36 * MiB;
constexpr size_t WS_MOD = 38 * MiB;
constexpr size_t WS_RSTDQ = 38 * MiB + 512 * 1024, WS_RSTDKV = 39 * MiB;
constexpr size_t WS_BAR = 39 * MiB + 512 * 1024;
constexpr size_t WS_XN = 40 * MiB;
constexpr size_t WS_R = 168 * MiB;
constexpr size_t WS_Q = 168 * MiB;
constexpr size_t WS_KV = 264 * MiB;
constexpr size_t WS_KPE = 392 * MiB;
constexpr size_t WS_H = 168 * MiB;
constexpr size_t WS_END = 424 * MiB;
constexpr size_t OUT_ST = 0, OUT_CB = 128 * MiB;

__device__ __forceinline__ int tok_seg(int t) { return t < 32768 ? (t >> 14) : 2 + ((t - 32768) >> 13); }
__device__ __forceinline__ int tok_pos(int t) { return t < 32768 ? (t & 16383) : (t & 8191); }
__device__ __forceinline__ unsigned f2bf(float f) { unsigned u = __builtin_bit_cast(unsigned, f); return (u + 0x7fffu + ((u >> 16) & 1u)) >> 16; }
__device__ __forceinline__ unsigned pk2(float lo, float hi) { return f2bf(lo) | (f2bf(hi) << 16); }
__device__ __forceinline__ float bf2f(unsigned short b) { return __builtin_bit_cast(float, (unsigned)b << 16); }
__device__ __forceinline__ float wave_sum(float v) {
#pragma unroll
    for (int o = 1; o < 64; o <<= 1) v += __shfl_xor(v, o);
    return v;
}

namespace pg8 {
constexpr int BM = 256, BK = 64, HALF = 128, HTB = HALF * BK * 2, STAGE_BYTES = 8 * HTB, NXCD = 8, WGM = 8;
__host__ __device__ __forceinline__ int lds_byte(int r, int c) { const int st = (r >> 4) * 2 + (c >> 5), rr = r & 15, cc = c & 31, ob = rr * 64 + cc * 2; return st * 1024 + (ob ^ (((ob >> 9) & 1) << 5)); }
__host__ __device__ __forceinline__ void stage_rc(int b, int& R, int& C) { const int st = b / 1024, sb = b % 1024, swz = sb ^ (((sb >> 9) & 1) << 5); R = (st >> 1) * 16 + swz / 64; C = (st & 1) * 32 + (swz % 64) / 2; }
__host__ __device__ __forceinline__ int perm32(int rho) { const int n = rho >> 4, i = rho & 15; return 8 * (i >> 2) + 4 * n + (i & 3); }
struct Unit { int pm, pn; };
struct Gemm { const bf16_t* A; const bf16_t* Bt; int M, N, K, lda; };
struct StaticOrder {
    int nM, nN, nwg, G, c;
    __host__ __device__ void init(int M, int N, int G_, int c_) { nM = M / BM; nN = N / BM; nwg = nM * nN; G = G_; c = c_; }
    __host__ __device__ bool next(int i, Unit& u) const {
        const long L = (long)i * G + c; if (L >= nwg) return false;
        int wgid = (int)L; { const int q = nwg / NXCD, r = nwg % NXCD, xcd = wgid % NXCD, off = wgid / NXCD; wgid = (xcd < r ? xcd * (q + 1) : r * (q + 1) + (xcd - r) * q) + off; }
        const int nig = WGM * nN, gid = wgid / nig, fm = gid * WGM, gsz = (nM - fm) < WGM ? (nM - fm) : WGM;
        u.pm = fm + ((wgid % nig) % gsz); u.pn = (wgid % nig) / gsz; return true;
    }
};

template <class Epi, bool ALIGN_EPI = true>
__device__ __forceinline__ void gemm_phase(LAS unsigned char* lds, const Gemm g, const StaticOrder& S, const Epi& E) {
    int tid = threadIdx.x; asm volatile("" : "+v"(tid));
    const int wid = __builtin_amdgcn_readfirstlane(tid >> 6), lane = tid & 63, wr = wid >> 2, wc = wid & 3, fr = lane & 15, fq = lane >> 4;
    int K = g.K, lda = g.lda; asm volatile("" : "+s"(K), "+s"(lda));
    const int nt = K / BK;
    unsigned voffA[2], voffB[2];
#pragma unroll
    for (int i = 0; i < 2; ++i) { int R, C; stage_rc(tid * 16 + i * 8192, R, C); const int Rb = Epi::PERM ? ((R & ~31) + perm32(R & 31)) : R;
        voffA[i] = (unsigned)(R * lda + C) * 2u; voffB[i] = (unsigned)(Rb * K + C) * 2u; }
    const size_t kstep = (size_t)(BK * 2);
    const size_t hstepA = (size_t)HALF * lda * 2, hstepB = (size_t)HALF * K * 2;
    const size_t tstepA = 2 * hstepA, tstepB = 2 * hstepB;
    const unsigned ldsw = (unsigned)wid * 1024u;
    const int aoff = lds_byte(wr * 64 + fr, fq * 8), boff = lds_byte(wc * 32 + fr, fq * 8);
#define PG8_SA(b, h) (((b) * 2 + (h)) * HTB)
#define PG8_SB(b, h) ((4 + (b) * 2 + (h)) * HTB)
#define PG8_STAGE(bufoff, gbase, voff) do { _Pragma("unroll") for (int _i = 0; _i < 2; ++_i) \
        __builtin_amdgcn_global_load_lds((const unsigned*)((const char*)(gbase) + (voff)[_i]), (LAS unsigned*)(lds + (bufoff) + ldsw + _i * 8192), 16, 0, 0); } while (0)
#define PG8_LDA(dst, b, h) do { _Pragma("unroll") for (int m = 0; m < 4; ++m) _Pragma("unroll") for (int k = 0; k < 2; ++k) dst[m][k] = *(const LAS bf16x8*)(lds + PG8_SA(b, h) + aoff + m * 2048 + k * 1024); } while (0)
#define PG8_LDB(dst, b, h) do { _Pragma("unroll") for (int n = 0; n < 2; ++n) _Pragma("unroll") for (int k = 0; k < 2; ++k) dst[n][k] = *(const LAS bf16x8*)(lds + PG8_SB(b, h) + boff + n * 2048 + k * 1024); } while (0)
#define PG8_MMA(ai, bj, At, Bt) do { __builtin_amdgcn_s_setprio(1); _Pragma("unroll") for (int m = 0; m < 4; ++m) _Pragma("unroll") for (int n = 0; n < 2; ++n) _Pragma("unroll") for (int k = 0; k < 2; ++k) \
        acc[ai][bj][m][n] = __builtin_amdgcn_mfma_f32_16x16x32_bf16(Bt[n][k], At[m][k], acc[ai][bj][m][n], 0, 0, 0); __builtin_amdgcn_s_setprio(0); } while (0)
#define PG8_WAIT_V(n) asm volatile("s_waitcnt vmcnt(" #n ")" ::: "memory")
#define PG8_WAIT_L(n) asm volatile("s_waitcnt lgkmcnt(" #n ")" ::: "memory")
#define PG8_BAR __builtin_amdgcn_s_barrier()
#define PG8_SCHED __builtin_amdgcn_sched_barrier(0)
    Unit cur, nxt; int ui = 0;
    if (!S.next(0, cur)) return;
    f32x4 acc[2][2][4][2];
#pragma unroll
    for (int a = 0; a < 2; ++a)
#pragma unroll
        for (int b = 0; b < 2; ++b)
#pragma unroll
            for (int m = 0; m < 4; ++m)
#pragma unroll
                for (int n = 0; n < 2; ++n) acc[a][b][m][n] = (f32x4){0.f, 0.f, 0.f, 0.f};
    bf16x8 At[4][2], B0[2][2], B1[2][2];
    const char* cA = (const char*)g.A + (size_t)cur.pm * tstepA; const char* cB = (const char*)g.Bt + (size_t)cur.pn * tstepB;
    PG8_STAGE(PG8_SB(0, 0), cB, voffB); PG8_STAGE(PG8_SB(0, 1), cB + hstepB, voffB); PG8_STAGE(PG8_SA(0, 0), cA, voffA); PG8_STAGE(PG8_SA(0, 1), cA + hstepA, voffA);
    if (wr == 1) PG8_BAR;
    PG8_WAIT_V(2); PG8_BAR;
    PG8_STAGE(PG8_SB(1, 0), cB + kstep, voffB); PG8_STAGE(PG8_SA(1, 0), cA + kstep, voffA); PG8_STAGE(PG8_SB(1, 1), cB + hstepB + kstep, voffB);
    PG8_WAIT_V(6); PG8_BAR;
    for (;;) {
        const bool has_next = S.next(ui + 1, nxt);
        const char* nA = has_next ? (const char*)g.A + (size_t)nxt.pm * tstepA : cA; const char* nB = has_next ? (const char*)g.Bt + (size_t)nxt.pn * tstepB : cB;
        for (int t = 0; t < nt; t += 2) {
            const bool last = (t == nt - 2);
            const char* a1 = cA + (size_t)(t + 1) * kstep;
            const char* a2 = last ? nA : cA + (size_t)(t + 2) * kstep; const char* b2 = last ? nB : cB + (size_t)(t + 2) * kstep;
            const char* a3 = a2 + kstep; const char* b3 = b2 + kstep;
            PG8_LDB(B0, 0, 0); PG8_LDB(B1, 0, 1); PG8_SCHED; PG8_LDA(At, 0, 0); PG8_STAGE(PG8_SA(1, 1), a1 + hstepA, voffA);
            PG8_WAIT_V(8); PG8_WAIT_L(0); PG8_BAR; PG8_MMA(0, 0, At, B0); PG8_MMA(0, 1, At, B1); PG8_BAR; PG8_SCHED;
            PG8_LDA(At, 0, 1); PG8_STAGE(PG8_SB(0, 0), b2, voffB); PG8_STAGE(PG8_SB(0, 1), b2 + hstepB, voffB); PG8_STAGE(PG8_SA(0, 0), a2, voffA);
            PG8_WAIT_V(8); PG8_WAIT_L(0); PG8_BAR; PG8_MMA(1, 0, At, B0); PG8_MMA(1, 1, At, B1); PG8_BAR; PG8_SCHED;
            PG8_LDB(B0, 1, 0); PG8_LDB(B1, 1, 1); PG8_SCHED; PG8_LDA(At, 1, 0); PG8_STAGE(PG8_SA(0, 1), a2 + hstepA, voffA);
            PG8_WAIT_V(8); PG8_WAIT_L(0); PG8_BAR; PG8_MMA(0, 0, At, B0); PG8_MMA(0, 1, At, B1); PG8_BAR; PG8_SCHED;
            PG8_LDA(At, 1, 1); PG8_STAGE(PG8_SB(1, 0), b3, voffB); PG8_STAGE(PG8_SB(1, 1), b3 + hstepB, voffB); PG8_STAGE(PG8_SA(1, 0), a3, voffA);
            PG8_WAIT_V(8); PG8_WAIT_L(0); PG8_BAR; PG8_MMA(1, 0, At, B0); PG8_MMA(1, 1, At, B1); PG8_BAR; PG8_SCHED;
        }
        if constexpr (ALIGN_EPI) { if (wr == 0) PG8_BAR; }
        E(acc, cur, wr, wc, fr, fq);
        if (!has_next) break;
#pragma unroll
        for (int a = 0; a < 2; ++a)
#pragma unroll
            for (int b = 0; b < 2; ++b)
#pragma unroll
                for (int m = 0; m < 4; ++m)
#pragma unroll
                    for (int n = 0; n < 2; ++n) acc[a][b][m][n] = (f32x4){0.f, 0.f, 0.f, 0.f};
        cur = nxt; cA = nA; cB = nB; ++ui;
        if constexpr (ALIGN_EPI) { if (wr == 1) PG8_BAR; }
    }
    PG8_WAIT_V(0);
    if constexpr (!ALIGN_EPI) { if (wr == 0) PG8_BAR; }
    PG8_BAR;
#undef PG8_SA
#undef PG8_SB
#undef PG8_STAGE
#undef PG8_LDA
#undef PG8_LDB
#undef PG8_MMA
#undef PG8_WAIT_V
#undef PG8_WAIT_L
#undef PG8_BAR
#undef PG8_SCHED
}
}
using pg8::Unit;
typedef const f32x4 (&AccRef)[2][2][4][2];

struct EpiRot {
    static constexpr bool PERM = false;
    bf16_t *RQ, *RK; const float *cos64, *sin64;
    __device__ __forceinline__ void operator()(AccRef acc, const Unit& u, int wr, int wc, int fr, int fq) const {
        const int row0 = u.pm * 256 + wr * 64 + fr, pn = u.pn;
        bf16_t* dst = pn < 2 ? RQ : RK; const float sc = pn < 2 ? 1.f : 0.08838834764831845f;
        const int i0 = wc * 16 + fq * 4;
#pragma unroll
        for (int ai = 0; ai < 2; ++ai)
#pragma unroll
            for (int m = 0; m < 4; ++m) { const int t = row0 + ai * 128 + m * 16, pos = tok_pos(t);
                const f32x4 c = *(const f32x4*)(cos64 + (size_t)pos * 64 + i0) * sc, s = *(const f32x4*)(sin64 + (size_t)pos * 64 + i0) * sc;
#pragma unroll
                for (int bj = 0; bj < 2; ++bj) { const f32x4 x1 = acc[ai][bj][m][0], x2 = acc[ai][bj][m][1];
                    const f32x4 o1 = x1 * c - x2 * s, o2 = x1 * s + x2 * c;
                    bf16_t* p = dst + (size_t)t * 512 + (pn & 1) * 256 + bj * 128 + i0;
                    *(u32x2*)p = (u32x2){pk2(o1[0], o1[1]), pk2(o1[2], o1[3])}; *(u32x2*)(p + 64) = (u32x2){pk2(o2[0], o2[1]), pk2(o2[2], o2[3])}; }
                asm volatile("" ::: "memory"); }
    }
};
struct EpiVG {
    static constexpr bool PERM = false;
    bf16_t *RV, *RG;
    __device__ __forceinline__ void operator()(AccRef acc, const Unit& u, int wr, int wc, int fr, int fq) const {
        const int row0 = u.pm * 256 + wr * 64 + fr, pn = u.pn;
        bf16_t* dst = pn < 2 ? RV : RG; const bool act = pn >= 2;
#pragma unroll
        for (int ai = 0; ai < 2; ++ai)
#pragma unroll
            for (int m = 0; m < 4; ++m) { const int t = row0 + ai * 128 + m * 16;
#pragma unroll
                for (int bj = 0; bj < 2; ++bj)
#pragma unroll
                    for (int n = 0; n < 2; ++n) { f32x4 v = acc[ai][bj][m][n];
                        if (act) {
#pragma unroll
                            for (int j = 0; j < 4; ++j) v[j] = v[j] / (1.f + __expf(-v[j])); }
                        bf16_t* p = dst + (size_t)t * 512 + (pn & 1) * 256 + bj * 128 + wc * 32 + n * 16 + fq * 4;
                        *(u32x2*)p = (u32x2){pk2(v[0], v[1]), pk2(v[2], v[3])}; }
                asm volatile("" ::: "memory"); }
    }
};
struct EpiQR {
    static constexpr bool PERM = false;
    bf16_t* Q; const float *cos32, *sin32;
    __device__ __forceinline__ void operator()(AccRef acc, const Unit& u, int wr, int wc, int fr, int fq) const {
        const int row0 = u.pm * 256 + wr * 64 + fr;
        const int i0 = (wc & 1) * 16 + fq * 4;
#pragma unroll
        for (int ai = 0; ai < 2; ++ai)
#pragma unroll
            for (int m = 0; m < 4; ++m) { const int t = row0 + ai * 128 + m * 16; const int pos = tok_pos(t);
                const f32x4 c = *(const f32x4*)(cos32 + (size_t)pos * 32 + i0), s = *(const f32x4*)(sin32 + (size_t)pos * 32 + i0);
#pragma unroll
                for (int bj = 0; bj < 2; ++bj) { const f32x4 x1 = acc[ai][bj][m][0], x2 = acc[ai][bj][m][1];
                    const f32x4 o1 = x1 * c - x2 * s, o2 = x1 * s + x2 * c;
                    bf16_t* p = Q + (size_t)t * 768 + 512 + (2 * bj + (wc >> 1)) * 64 + i0;
                    *(u32x2*)p = (u32x2){pk2(o1[0], o1[1]), pk2(o1[2], o1[3])}; *(u32x2*)(p + 32) = (u32x2){pk2(o2[0], o2[1]), pk2(o2[2], o2[3])}; }
                asm volatile("" ::: "memory"); }
    }
};
template <int ACT  > struct EpiBf16 {
    static constexpr bool PERM = true;
    bf16_t* O; int ldc; const float* rowscale;
    __device__ __forceinline__ void operator()(AccRef acc, const Unit& u, int wr, int wc, int fr, int fq) const {
        const int row0 = u.pm * 256 + wr * 64 + fr, col0 = u.pn * 256 + wc * 32 + 8 * fq;
#pragma unroll
        for (int ai = 0; ai < 2; ++ai)
#pragma unroll
            for (int m = 0; m < 4; ++m) { const int t = row0 + ai * 128 + m * 16; float rs = 1.f; if (ACT == 0) rs = rowscale[t];
                bf16_t* rowp = O + (size_t)t * ldc + col0;
#pragma unroll
                for (int bj = 0; bj < 2; ++bj) { f32x4 v0 = acc[ai][bj][m][0], v1 = acc[ai][bj][m][1];
                    if (ACT == 1) {
#pragma unroll
                        for (int j = 0; j < 4; ++j) { const float a = fmaxf(v0[j], 0.f), b = fmaxf(v1[j], 0.f); v0[j] = a * a; v1[j] = b * b; }
                    } else if (ACT == 0) { v0 = v0 * rs; v1 = v1 * rs; }
                    *(u32x4*)(rowp + bj * 128) = (u32x4){pk2(v0[0], v0[1]), pk2(v0[2], v0[3]), pk2(v1[0], v1[1]), pk2(v1[2], v1[3])}; }
                asm volatile("" ::: "memory"); }
    }
};
struct EpiResid {
    static constexpr bool PERM = false;
    const float *basep, *bases; float* out; const float* gate; int row_base;
    __device__ __forceinline__ void operator()(AccRef acc, const Unit& u, int wr, int wc, int fr, int fq) const {
        const int trow0 = row_base + u.pm * 256; const int seg = tok_seg(trow0);
        const float* base = basep ? (trow0 < 32768 ? basep + (size_t)trow0 * DM : bases + (size_t)(trow0 - 32768) * DM) : out + (size_t)trow0 * DM;
        float* o = out + (size_t)trow0 * DM;
        const int col0 = u.pn * 256 + wc * 32 + 4 * fq;
        f32x4 gv[2][2];
#pragma unroll
        for (int bj = 0; bj < 2; ++bj)
#pragma unroll
            for (int n = 0; n < 2; ++n) gv[bj][n] = *(const f32x4*)(gate + (size_t)seg * NMOD + col0 + bj * 128 + n * 16);
#pragma unroll
        for (int ai = 0; ai < 2; ++ai)
#pragma unroll
            for (int m = 0; m < 4; ++m) { const size_t off = (size_t)(ai * 128 + wr * 64 + m * 16 + fr) * DM + col0;
#pragma unroll
                for (int bj = 0; bj < 2; ++bj)
#pragma unroll
                    for (int n = 0; n < 2; ++n) { const f32x4 b = *(const f32x4*)(base + off + bj * 128 + n * 16);
                        *(f32x4*)(o + off + bj * 128 + n * 16) = b * DN_ALPHA + gv[bj][n] * acc[ai][bj][m][n]; }
                asm volatile("" ::: "memory"); }
    }
};

namespace att {
constexpr int NW = 8, QBLK = 32, KVBLK = 64;
constexpr float SCALE = 0.07216878364870322f;
constexpr float THR = 8.f;
constexpr int LDQ = 768, LDK = 1024, LDR = 64, LDO = 1024;
constexpr int SHM_V = 16384, SHM_K = 16384, SHM_R = 8192;
constexpr int OFF_V = 0, OFF_K = 2 * SHM_V, OFF_R = OFF_K + 2 * SHM_K, OFF_WS = OFF_R + 2 * SHM_R, OFF_QR = OFF_WS + 2048;
#define KSWZ(row, colB) ((row) * 256 + ((colB) ^ (((row) & 7) << 4)))
#define RSWZ(row, ch) ((row) * 128 + ((((ch) ^ ((row) >> 1)) & 7) << 4))
#define SBAR() __builtin_amdgcn_sched_barrier(0)
__device__ __forceinline__ int crow(int r, int hi) { return (r & 3) + 8 * (r >> 2) + 4 * hi; }
__device__ __forceinline__ unsigned cvtpk(float lo, float hi) { unsigned r; asm volatile("v_cvt_pk_bf16_f32 %0, %1, %2" : "=v"(r) : "v"(lo), "v"(hi)); return r; }
__device__ __forceinline__ void partialSM(f32x16& p0, f32x16& p1, float& m_reg, float& mn, float& alpha, const float C, const float thr_raw) {
    float pmax = p0[0];
#pragma unroll
    for (int r = 1; r < 16; ++r) pmax = fmaxf(pmax, p0[r]);
#pragma unroll
    for (int r = 0; r < 16; ++r) pmax = fmaxf(pmax, p1[r]);
    { auto rr = __builtin_amdgcn_permlane32_swap(__float_as_uint(pmax), __float_as_uint(pmax), false, false);
      pmax = fmaxf(__uint_as_float(rr[0]), __uint_as_float(rr[1])); }
    if (__builtin_expect(__all(pmax - m_reg <= thr_raw), 1)) { mn = m_reg; alpha = 1.f; }
    else { mn = fmaxf(m_reg, pmax); alpha = __builtin_amdgcn_exp2f((m_reg - mn) * C); m_reg = mn; }
    const float mnC = -mn * C;
#pragma unroll
    for (int r = 0; r < 16; ++r) p0[r] = fmaf(p0[r], C, mnC);
#pragma unroll
    for (int r = 0; r < 16; ++r) p1[r] = fmaf(p1[r], C, mnC);
#pragma unroll
    for (int r = 0; r < 16; ++r) p0[r] = __builtin_amdgcn_exp2f(p0[r]);
}
__device__ __forceinline__ void finishSM(f32x16& p0, f32x16& p1, float alpha, float& l_reg, bf16x8& pa0, bf16x8& pa1, bf16x8& pa2, bf16x8& pa3) {
#pragma unroll
    for (int r = 0; r < 16; ++r) p1[r] = __builtin_amdgcn_exp2f(p1[r]);
    float ps = 0;
#pragma unroll
    for (int r = 0; r < 16; ++r) ps += p0[r];
#pragma unroll
    for (int r = 0; r < 16; ++r) ps += p1[r];
    { auto rr = __builtin_amdgcn_permlane32_swap(__float_as_uint(ps), __float_as_uint(ps), false, false);
      ps = __uint_as_float(rr[0]) + __uint_as_float(rr[1]); }
    l_reg = l_reg * alpha + ps;
#define PK4(P, BASE, OUT) do { unsigned a0 = cvtpk(P[BASE + 0], P[BASE + 1]), a1 = cvtpk(P[BASE + 2], P[BASE + 3]);   \
    unsigned b0 = cvtpk(P[BASE + 4], P[BASE + 5]), b1 = cvtpk(P[BASE + 6], P[BASE + 7]);                              \
    auto r0 = __builtin_amdgcn_permlane32_swap(a0, b0, false, false); auto r1 = __builtin_amdgcn_permlane32_swap(a1, b1, false, false); \
    u32x4 w = {r0[0], r1[0], r0[1], r1[1]}; OUT = *reinterpret_cast<bf16x8*>(&w); } while (0)
    PK4(p0, 0, pa0); PK4(p0, 8, pa1); PK4(p1, 0, pa2); PK4(p1, 8, pa3);
#undef PK4
}
__device__ __forceinline__ void qkt(f32x16& p0, f32x16& p1, const char* Ks, const char* Rs, const bf16x8* qr, const char* qrl, int r32, int hi) {
    p0 = f32x16{}; p1 = f32x16{};
#pragma unroll
    for (int d0 = 0; d0 < 8; ++d0) { const int cb = (d0 * 16 + hi * 8) * 2;
        const bf16x8 b0 = *reinterpret_cast<const bf16x8*>(Ks + KSWZ(r32, cb));
        const bf16x8 b1 = *reinterpret_cast<const bf16x8*>(Ks + KSWZ(32 + r32, cb));
        p0 = __builtin_amdgcn_mfma_f32_32x32x16_bf16(b0, qr[d0], p0, 0, 0, 0);
        p1 = __builtin_amdgcn_mfma_f32_32x32x16_bf16(b1, qr[d0], p1, 0, 0, 0); }
#pragma unroll
    for (int d1 = 0; d1 < 4; ++d1) { const int ch = d1 * 2 + hi;
        const bf16x8 b0 = *reinterpret_cast<const bf16x8*>(Rs + RSWZ(r32, ch));
        const bf16x8 b1 = *reinterpret_cast<const bf16x8*>(Rs + RSWZ(32 + r32, ch));
        const bf16x8 qf = *reinterpret_cast<const bf16x8*>(qrl + d1 * 1024);
        p0 = __builtin_amdgcn_mfma_f32_32x32x16_bf16(b0, qf, p0, 0, 0, 0);
        p1 = __builtin_amdgcn_mfma_f32_32x32x16_bf16(b1, qf, p1, 0, 0, 0); }
}
__device__ __forceinline__ int v_st(int k, int c) { const int kk = (k & ~0xC) | ((k & 4) << 1) | ((k & 8) >> 1); return ((kk >> 3) * 4 + (c >> 5)) * 512 + ((kk & 7) * 32 + (c & 31)) * 2; }
__device__ __forceinline__ int v_rd_base(int lane) { return ((lane & 3) << 3) | (((lane >> 2) & 3) << 6) | (((lane >> 4) & 1) << 5) | (((lane >> 5) & 1) << 8); }
constexpr int v_rd_off(int d0, int ks, int half) { return d0 * 512 + ks * 4096 + half * 2048; }
template <int OFF> __device__ __forceinline__ s16x4 tr_read(int vb) {
    s16x4 r; asm volatile("ds_read_b64_tr_b16 %0, %1 offset:%2" : "=&v"(r) : "v"(vb), "i"(OFF) : "memory"); return r;
}
template <int D0> __device__ __forceinline__ void pv_one(f32x16& od, int vb, bf16x8 pa0, bf16x8 pa1, bf16x8 pa2, bf16x8 pa3) {
    const s16x4 l0 = tr_read<v_rd_off(D0, 0, 0)>(vb), h0 = tr_read<v_rd_off(D0, 0, 1)>(vb), l1 = tr_read<v_rd_off(D0, 1, 0)>(vb), h1 = tr_read<v_rd_off(D0, 1, 1)>(vb);
    const s16x4 l2 = tr_read<v_rd_off(D0, 2, 0)>(vb), h2 = tr_read<v_rd_off(D0, 2, 1)>(vb), l3 = tr_read<v_rd_off(D0, 3, 0)>(vb), h3 = tr_read<v_rd_off(D0, 3, 1)>(vb);
    asm volatile("s_waitcnt lgkmcnt(0)" ::: "memory"); SBAR();
#define PK(L, H) (bf16x8){L[0], L[1], L[2], L[3], H[0], H[1], H[2], H[3]}
    od = __builtin_amdgcn_mfma_f32_32x32x16_bf16(pa0, PK(l0, h0), od, 0, 0, 0);
    od = __builtin_amdgcn_mfma_f32_32x32x16_bf16(pa1, PK(l1, h1), od, 0, 0, 0);
    od = __builtin_amdgcn_mfma_f32_32x32x16_bf16(pa2, PK(l2, h2), od, 0, 0, 0);
    od = __builtin_amdgcn_mfma_f32_32x32x16_bf16(pa3, PK(l3, h3), od, 0, 0, 0);
#undef PK
}
__device__ __forceinline__ void pv_d0(f32x16* o, int vb, bf16x8 pa0, bf16x8 pa1, bf16x8 pa2, bf16x8 pa3) {
    pv_one<0>(o[0], vb, pa0, pa1, pa2, pa3); pv_one<1>(o[1], vb, pa0, pa1, pa2, pa3); pv_one<2>(o[2], vb, pa0, pa1, pa2, pa3); pv_one<3>(o[3], vb, pa0, pa1, pa2, pa3);
}
__device__ __forceinline__ void attn_unit(const bf16_t* Qn, const bf16_t* Qr, const float* rq, const bf16_t* Kh, const bf16_t* Vh, const bf16_t* Rh, bf16_t* Ob, int seq, char* lds) {
    int tid = threadIdx.x; asm volatile("" : "+v"(tid));
    const int wid = tid >> 6, lane = tid & 63, r32 = lane & 31, hi = lane >> 5;
    char* V_lds = lds + OFF_V; char* K_lds = lds + OFF_K; char* R_lds = lds + OFF_R;
    float* ws = (float*)(lds + OFF_WS) + wid * 64; float* li_l = ws; float* al_l = ws + 32;
    float m_reg = -1e30f, l_reg = 0; f32x16 o[4] = {}; bf16x8 qr[8]; char* qrl = lds + OFF_QR + wid * 4096 + lane * 16;
    const float rqv = rq[wid * QBLK + r32]; const float Cq = SCALE * 1.4426950408889634f * rqv, thr_raw = THR / (SCALE * rqv);
    { const bf16_t* Qw = Qn + (long)(wid * QBLK + r32) * LDQ + hi * 8;
#pragma unroll
      for (int d0 = 0; d0 < 8; ++d0) qr[d0] = *reinterpret_cast<const bf16x8*>(Qw + d0 * 16);
      const bf16_t* Qw2 = Qr + (long)(wid * QBLK + r32) * LDQ + hi * 8;
#pragma unroll
      for (int d0 = 0; d0 < 4; ++d0) *reinterpret_cast<bf16x8*>(qrl + d0 * 1024) = *reinterpret_cast<const bf16x8*>(Qw2 + d0 * 16); }
    const int sr = tid >> 4, sc = (tid & 15) * 8, vst0 = v_st(sr, sc), vst1 = v_st(32 + sr, sc);
    const int rr_ = tid >> 3, rc_ = tid & 7, rst = RSWZ(rr_, rc_);
    const int vb0 = (int)(uintptr_t)V_lds + v_rd_base(lane);
    struct { bf16x8 vs0, vs1, ks0, ks1, rs; } sr_[1];
#define SLOAD(i, k0) do { sr_[i].vs0 = *reinterpret_cast<const bf16x8*>(&Vh[(long)((k0) + sr) * LDK + sc]); sr_[i].vs1 = *reinterpret_cast<const bf16x8*>(&Vh[(long)((k0) + 32 + sr) * LDK + sc]); \
    sr_[i].ks0 = *reinterpret_cast<const bf16x8*>(&Kh[(long)((k0) + sr) * LDK + sc]); sr_[i].ks1 = *reinterpret_cast<const bf16x8*>(&Kh[(long)((k0) + 32 + sr) * LDK + sc]); \
    sr_[i].rs = *reinterpret_cast<const bf16x8*>(&Rh[(long)((k0) + rr_) * LDR + rc_ * 8]); } while (0)
#define SWRITE(b, i) do { *(bf16x8*)(V_lds + (b) * SHM_V + vst0) = sr_[i].vs0; *(bf16x8*)(V_lds + (b) * SHM_V + vst1) = sr_[i].vs1; const int kc = sc * 2; \
    *(bf16x8*)(K_lds + (b) * SHM_K + KSWZ(sr, kc)) = sr_[i].ks0; *(bf16x8*)(K_lds + (b) * SHM_K + KSWZ(32 + sr, kc)) = sr_[i].ks1; \
    *(bf16x8*)(R_lds + (b) * SHM_R + rst) = sr_[i].rs; } while (0)
#define SWAIT() asm volatile("s_waitcnt vmcnt(0)" ::: "memory")
#define RESC(a) do { if (__any((a) < 1.f)) { if (hi == 0) al_l[r32] = (a); asm volatile("s_waitcnt lgkmcnt(0)" ::: "memory"); \
    _Pragma("unroll") for (int d = 0; d < 4; ++d) _Pragma("unroll") for (int r = 0; r < 16; ++r) o[d][r] *= al_l[crow(r, hi)]; } } while (0)
    f32x16 pA0, pA1, pB0, pB1; float mnA, mnB, alA, alB; bf16x8 pa0, pa1, pa2, pa3; const int NT = seq / KVBLK;
    SLOAD(0, 0); SWAIT(); SWRITE(0, 0); __syncthreads();
    qkt(pA0, pA1, K_lds, R_lds, qr, qrl, r32, hi); partialSM(pA0, pA1, m_reg, mnA, alA, Cq, thr_raw);
    SLOAD(0, KVBLK);
    SWAIT(); SWRITE(1, 0); __syncthreads();
    for (int j = 1; j + 1 < NT; j += 2) {
        SBAR(); qkt(pB0, pB1, K_lds + SHM_K, R_lds + SHM_R, qr, qrl, r32, hi);
        finishSM(pA0, pA1, alA, l_reg, pa0, pa1, pa2, pa3); SBAR();
        SLOAD(0, (j + 1) * KVBLK); SBAR();
        pv_d0(o, vb0, pa0, pa1, pa2, pa3); partialSM(pB0, pB1, m_reg, mnB, alB, Cq, thr_raw);
        __syncthreads(); SWAIT(); SWRITE(0, 0);
        RESC(alB); __syncthreads();
        SBAR(); qkt(pA0, pA1, K_lds, R_lds, qr, qrl, r32, hi);
        finishSM(pB0, pB1, alB, l_reg, pa0, pa1, pa2, pa3); SBAR();
        SLOAD(0, (j + 2) * KVBLK); SBAR();
        pv_d0(o, vb0 + SHM_V, pa0, pa1, pa2, pa3); partialSM(pA0, pA1, m_reg, mnA, alA, Cq, thr_raw);
        __syncthreads(); SWAIT(); SWRITE(1, 0);
        RESC(alA); __syncthreads();
    }
    SBAR(); qkt(pB0, pB1, K_lds + SHM_K, R_lds + SHM_R, qr, qrl, r32, hi);
    finishSM(pA0, pA1, alA, l_reg, pa0, pa1, pa2, pa3); SBAR();
    pv_d0(o, vb0, pa0, pa1, pa2, pa3); partialSM(pB0, pB1, m_reg, mnB, alB, Cq, thr_raw);
    __syncthreads(); RESC(alB);
    finishSM(pB0, pB1, alB, l_reg, pa0, pa1, pa2, pa3); SBAR();
    pv_d0(o, vb0 + SHM_V, pa0, pa1, pa2, pa3);
    if (hi == 0) li_l[r32] = l_reg; asm volatile("s_waitcnt lgkmcnt(0)" ::: "memory");
    float rli[16];
#pragma unroll
    for (int r = 0; r < 16; ++r) rli[r] = __builtin_amdgcn_rcpf(li_l[crow(r, hi)]);
    bf16_t* Ow = Ob + (long)(wid * QBLK) * LDO;
#pragma unroll
    for (int r = 0; r < 16; ++r) { const int orow = crow(r, hi);
#pragma unroll
        for (int d0 = 0; d0 < 4; ++d0) Ow[(long)orow * LDO + d0 * 32 + r32] = (bf16_t)f2bf(o[d0][r] * rli[r]); }
    __syncthreads();
#undef SLOAD
#undef SWRITE
#undef SWAIT
#undef RESC
}
#undef SBAR
}

__device__ __forceinline__ int tbyte(int row, int col) { return row * 256 + ((((col >> 3) ^ row) & 15) << 4) + (col & 7) * 2; }
__device__ __forceinline__ bf16x8 lds_frag(const char* base, int row, int col) { return *reinterpret_cast<const bf16x8*>(base + tbyte(row, col)); }
#define MFMA16(a, b, c) __builtin_amdgcn_mfma_f32_16x16x32_bf16(a, b, c, 0, 0, 0)


#define XB_TMO      128
#define XB_XCNT(j)  (256  + 64 * (j))
#define XB_XSUB(j)  (1280 + 64 * (j))
#define XB_XGEN(j)  (2304 + 64 * (j))
#define XB_TOP      3328
#define XB_TOPGEN   3392
#define XCD_BAR_WORDS 3456
#define XB_SPIN_CAP (1u << 18)
__device__ __forceinline__ unsigned xb_ld(unsigned* p)              { return __hip_atomic_load(p, __ATOMIC_RELAXED, __HIP_MEMORY_SCOPE_AGENT); }
__device__ __forceinline__ unsigned xb_add(unsigned* p, unsigned v) { return __hip_atomic_fetch_add(p, v, __ATOMIC_RELAXED, __HIP_MEMORY_SCOPE_AGENT); }
__device__ __forceinline__ unsigned xb_xcc_id() { return (unsigned)__builtin_amdgcn_s_getreg((3 << 11) | 20) & 0xFu; }
#define XB_SPIN(cond, bar) do { unsigned _sp = 0; while (cond) { __builtin_amdgcn_s_sleep(1); \
    if ((++_sp & 255u) == 0u) { if (xb_ld(&(bar)[XB_TMO])) break; if (_sp > XB_SPIN_CAP) { atomicAdd(&(bar)[XB_TMO], 1u); break; } } } } while (0)
struct XcdBarrier { unsigned* bar; unsigned x; volatile LAS unsigned* st; };
__device__ __forceinline__ XcdBarrier xcd_barrier_post(unsigned* bar, volatile LAS unsigned* st) {
    XcdBarrier b; b.bar = bar; b.x = xb_xcc_id(); b.st = st;
    if (threadIdx.x == 0) (void)xb_add(&bar[XB_XCNT(b.x)], 1u);
    return b;
}
__device__ __forceinline__ void xcd_barrier_complete(unsigned* bar, unsigned x, unsigned& nloc, unsigned& nx) {
    const unsigned G = gridDim.x * gridDim.y * gridDim.z;
    unsigned sum, cnt, mine, sp = 0u;
    for (;;) {
        sum = 0u; cnt = 0u; mine = 0u;
#pragma unroll
        for (unsigned j = 0; j < 16; ++j) { const unsigned c = xb_ld(&bar[XB_XCNT(j)]); sum += c; cnt += (c > 0u) ? 1u : 0u; mine = (j == x) ? c : mine; }
        if (sum == G) break;
        __builtin_amdgcn_s_sleep(1);
        if ((++sp & 255u) == 0u) { if (xb_ld(&bar[XB_TMO])) break; if (sp > XB_SPIN_CAP) { atomicAdd(&bar[XB_TMO], 1u); break; } }
    }
    nloc = mine > 0u ? mine : 1u; nx = cnt > 0u ? cnt : 1u;
}
__device__ __forceinline__ void xcd_barrier(const XcdBarrier& b) {
    asm volatile("s_waitcnt vmcnt(0)" ::: "memory");
    __syncthreads();
    if (threadIdx.x == 0) {
        unsigned* bar = b.bar;
        __builtin_amdgcn_s_waitcnt(0);
        unsigned nloc = b.st[0], nx = b.st[1];
        if (nloc == 0u) { xcd_barrier_complete(bar, b.x, nloc, nx); b.st[0] = nloc; b.st[1] = nx; }
        const unsigned old = xb_add(&bar[XB_XSUB(b.x)], 1u);
        const unsigned gen = old / nloc;
        if (old + 1u == (gen + 1u) * nloc) {
            __builtin_amdgcn_fence(__ATOMIC_RELEASE, "agent");
            asm volatile("s_waitcnt vmcnt(0)" ::: "memory");
            const unsigned og = xb_add(&bar[XB_TOP], 1u);
            const unsigned tg = og / nx;
            if (og + 1u == (tg + 1u) * nx) xb_add(&bar[XB_TOPGEN], 1u);
            else XB_SPIN(xb_ld(&bar[XB_TOPGEN]) == tg, bar);
            __builtin_amdgcn_fence(__ATOMIC_ACQUIRE, "agent");
            xb_add(&bar[XB_XGEN(b.x)], 1u);
            asm volatile("s_waitcnt vmcnt(0)" ::: "memory");
        } else {
            XB_SPIN(xb_ld(&bar[XB_XGEN(b.x)]) == gen, bar);
            __builtin_amdgcn_fence(__ATOMIC_ACQUIRE, "agent");
            asm volatile("s_waitcnt vmcnt(0)" ::: "memory");
        }
    }
    __syncthreads();
}

#ifndef REPM
#define REPM 0
#endif
#define REPS(b) (((REPM >> (b)) & 1) ? 2 : 1)
struct Args {
    const float* in[21]; float* out; unsigned char* ws;
};

__global__ void __launch_bounds__(512) fwd_kernel(Args a) {
    extern __shared__ __attribute__((aligned(16))) unsigned char lds_raw[];
    cg::grid_group grid = cg::this_grid();
    char* lds = (char*)lds_raw;
    LAS unsigned char* lds3 = (LAS unsigned char*)lds_raw;
    const int tid = threadIdx.x, lane = tid & 63, wave = tid >> 6;
    const int G = gridDim.x, bx = blockIdx.x;
    const int gw = bx * 8 + wave, NGW = G * 8;
    unsigned char* ws = a.ws;
    const float *x_prompt = a.in[0], *x_sample = a.in[1], *c_prompt = a.in[2], *c_sample = a.in[3], *w_ada = a.in[4], *b_ada = a.in[5], *w_in = a.in[6],
                *ret_decay_f = a.in[7], *ret_decay_b = a.in[8], *ret_gn_w = a.in[9], *q_norm_w = a.in[10], *w_uq = a.in[11], *kv_norm_w = a.in[12], *w_ukv = a.in[13],
                *w_o = a.in[14], *ln1_w = a.in[15], *ln1_b = a.in[16], *w_up = a.in[17], *w_down = a.in[18], *ln2_w = a.in[19], *ln2_b = a.in[20];
    float* out = a.out;
    bf16_t *WinT = (bf16_t*)(ws + WS_WIN), *WuqT = (bf16_t*)(ws + WS_WUQ), *WukvT = (bf16_t*)(ws + WS_WUKV), *WoT = (bf16_t*)(ws + WS_WO), *WupT = (bf16_t*)(ws + WS_WUP), *WdnT = (bf16_t*)(ws + WS_WDN);
    float *cos64 = (float*)(ws + WS_COS64), *sin64 = (float*)(ws + WS_SIN64), *cos32 = (float*)(ws + WS_COS32), *sin32 = (float*)(ws + WS_SIN32);
    float *mod = (float*)(ws + WS_MOD), *rstdq = (float*)(ws + WS_RSTDQ), *rstdkv = (float*)(ws + WS_RSTDKV);
    bf16_t *XN = (bf16_t*)(ws + WS_XN), *MIX = XN;
    bf16_t *RQ = (bf16_t*)(ws + WS_R), *RK = RQ + (size_t)NTOK * 512, *RV = RK + (size_t)NTOK * 512, *RG = RV + (size_t)NTOK * 512;
    bf16_t *Qb = (bf16_t*)(ws + WS_Q), *KVb = (bf16_t*)(ws + WS_KV), *KPE = (bf16_t*)(ws + WS_KPE), *Hb = (bf16_t*)(ws + WS_H);
    bf16_t *ST = (bf16_t*)((unsigned char*)out + OUT_ST), *CB = (bf16_t*)((unsigned char*)out + OUT_CB);
    volatile LAS unsigned* bst = (volatile LAS unsigned*)(lds3 + 139264);
    if (tid < 2) bst[tid] = 0u;
    __syncthreads();
    const XcdBarrier xbar = xcd_barrier_post((unsigned*)(ws + WS_BAR), bst);
#define GSYNC() xcd_barrier(xbar)

    for (int rep = 0; rep < REPS(0); ++rep) {
        float* scl = (float*)lds; float* part = (float*)(lds + 24576);
        for (int u = bx; u < 96; u += G) {
            for (int i = tid; i < 6144; i += 512) { const int b = i >> 10, k = i & 1023; const float c = b < 2 ? c_prompt[b * 1024 + k] : c_sample[(b - 2) * 1024 + k]; scl[i] = c / (1.f + __expf(-c)); }
            __syncthreads();
            const int col = u * 64 + lane; float acc[6] = {0.f, 0.f, 0.f, 0.f, 0.f, 0.f};
#pragma unroll 8
            for (int k = wave * 128; k < wave * 128 + 128; ++k) { const float w = w_ada[(size_t)k * NMOD + col];
#pragma unroll
                for (int b = 0; b < 6; ++b) acc[b] += scl[b * 1024 + k] * w; }
#pragma unroll
            for (int b = 0; b < 6; ++b) part[(wave * 6 + b) * 64 + lane] = acc[b];
            __syncthreads();
            if (tid < 384) { const int b = tid >> 6, l = tid & 63; float s = b_ada[u * 64 + l];
#pragma unroll
                for (int w = 0; w < 8; ++w) s += part[(w * 6 + b) * 64 + l];
                mod[b * NMOD + u * 64 + l] = s; }
            __syncthreads();
        }
        float* scr = (float*)(lds + wave * 16384);
        constexpr int I_IN = 16 * 88, I_UQ = 6 * 24, I_UKV = 4 * 32, I_O = 16 * 32, I_UP = 16 * 128, I_DN = 64 * 32;
        constexpr int NITEMS = I_IN + I_UQ + I_UKV + I_O + I_UP + I_DN;
        for (int it = gw; it < NITEMS; it += NGW) {
            int r = it, which; const float* W; const float* kscale = nullptr; bf16_t* WT; int K, ldw, ndest;
            if (r < I_IN) { which = 0; W = w_in; WT = WinT; K = 1024; ldw = 2752; ndest = 2816; }
            else if ((r -= I_IN) < I_UQ) { which = 1; W = w_uq; WT = WuqT; K = 384; ldw = 768; ndest = 768; kscale = q_norm_w; }
            else if ((r -= I_UQ) < I_UKV) { which = 2; W = w_ukv; WT = WukvT; K = 256; ldw = 1024; ndest = 1024; kscale = kv_norm_w; }
            else if ((r -= I_UKV) < I_O) { which = 2; W = w_o; WT = WoT; K = 1024; ldw = 1024; ndest = 1024; }
            else if ((r -= I_O) < I_UP) { which = 2; W = w_up; WT = WupT; K = 1024; ldw = 4096; ndest = 4096; }
            else { r -= I_UP; which = 2; W = w_down; WT = WdnT; K = 4096; ldw = 1024; ndest = 1024; }
            const int nblk = ndest / 32, kb = r / nblk, nb = r % nblk, k0 = 64 * kb, n0 = 32 * nb;
            const int nd = n0 + (lane & 31); int src;
            if (which == 0) { if (nd < 1024) { const int p = nd & 127; src = (nd & ~127) + (p >> 5) * 16 + (p & 15) + 64 * ((p >> 4) & 1); } else src = nd < 2752 ? nd : -1; }
            else if (which == 1) { if (nd < 512) src = (nd >> 7) * 192 + (nd & 127); else { const int q = nd - 512, bj = q >> 7, p = q & 127, wc = p >> 5, n = (p >> 4) & 1, rr = p & 15; src = (2 * bj + (wc >> 1)) * 192 + 128 + (wc & 1) * 16 + rr + 32 * n; } }
            else src = nd;
#pragma unroll 8
            for (int i = 0; i < 32; ++i) { const int kk = 2 * i + (lane >> 5); float v = 0.f;
                if (src >= 0) { v = W[(size_t)(k0 + kk) * ldw + src]; if (kscale) v *= kscale[k0 + kk]; }
                scr[kk * 33 + (lane & 31)] = v; }
            asm volatile("s_waitcnt lgkmcnt(0)" ::: "memory");
            const int c = lane & 7;
#pragma unroll
            for (int j = 0; j < 4; ++j) { const int n = (lane >> 3) + 8 * j; const float* s = scr + (8 * c) * 33 + n;
                u32x4 o; o.x = pk2(s[0 * 33], s[1 * 33]); o.y = pk2(s[2 * 33], s[3 * 33]); o.z = pk2(s[4 * 33], s[5 * 33]); o.w = pk2(s[6 * 33], s[7 * 33]);
                *(u32x4*)(WT + (size_t)(n0 + n) * K + k0 + 8 * c) = o; }
            asm volatile("s_waitcnt lgkmcnt(0)" ::: "memory");
        }
        for (int i = bx * 512 + tid; i < 16384 * 96; i += G * 512) {
            int pos, fi; float inv; float *cp, *sp;
            if (i < 16384 * 64) { pos = i >> 6; fi = i & 63; inv = exp2f(-(float)fi * (13.287712379549449f / 64.f)); cp = cos64 + i; sp = sin64 + i; }
            else { const int j = i - 16384 * 64; pos = j >> 5; fi = j & 31; inv = exp2f(-(float)fi * (13.287712379549449f / 32.f)); cp = cos32 + j; sp = sin32 + j; }
            const float ang = (float)pos * inv;
            double rev = (double)ang * 0.15915494309189535; rev -= rint(rev);
            const float rf = (float)rev;
            *cp = __builtin_amdgcn_cosf(rf); *sp = __builtin_amdgcn_sinf(rf);
        }
    }
    grid.sync();

    for (int rep = 0; rep < REPS(1); ++rep)
    for (int m = gw; m < NTOK; m += NGW) {
        const float* xrow = m < 32768 ? x_prompt + (size_t)m * DM : x_sample + (size_t)(m - 32768) * DM;
        const float* md = mod + (size_t)tok_seg(m) * NMOD;
        const f32x4* xr = (const f32x4*)xrow + lane;
        f32x4 v[4]; float s = 0.f;
#pragma unroll
        for (int j = 0; j < 4; ++j) { v[j] = xr[64 * j]; s += (v[j].x + v[j].y) + (v[j].z + v[j].w); }
        const float mean = wave_sum(s) * (1.f / DM); float s2 = 0.f;
#pragma unroll
        for (int j = 0; j < 4; ++j) { v[j] = v[j] - mean; s2 += (v[j].x * v[j].x + v[j].y * v[j].y) + (v[j].z * v[j].z + v[j].w * v[j].w); }
        const float rstd = 1.f / sqrtf(wave_sum(s2) * (1.f / DM) + LN_EPS);
        u32x2* o8 = (u32x2*)(XN + (size_t)m * DM) + lane;
#pragma unroll
        for (int j = 0; j < 4; ++j) { const int c = 4 * lane + 256 * j; const f32x4 sh = *(const f32x4*)(md + c), sc = *(const f32x4*)(md + 1024 + c);
            const f32x4 h = v[j] * rstd * (sc + 1.f) + sh; o8[64 * j] = (u32x2){pk2(h.x, h.y), pk2(h.z, h.w)}; }
    }
    GSYNC();

    for (int rep = 0; rep < REPS(2); ++rep) {
    {
        pg8::Gemm g{XN, WinT, NTOK, 1024, DM, DM}; pg8::StaticOrder S; S.init(NTOK, 1024, G, bx);
        EpiRot E{RQ, RK, cos64, sin64};
        pg8::gemm_phase<EpiRot>(lds3, g, S, E);
    }
    {
        pg8::Gemm g{XN, WinT + (size_t)1024 * DM, NTOK, 1024, DM, DM}; pg8::StaticOrder S; S.init(NTOK, 1024, G, bx);
        EpiVG E{RV, RG};
        pg8::gemm_phase<EpiVG>(lds3, g, S, E);
    }
    {
        pg8::Gemm g{XN, WinT + (size_t)2048 * DM, NTOK, 768, DM, DM}; pg8::StaticOrder S; S.init(NTOK, 768, G, bx);
        EpiBf16<2> E{CB, 768, nullptr};
        pg8::gemm_phase<EpiBf16<2>>(lds3, g, S, E);
    }
    }
    GSYNC();

    {
        char *KtF = lds, *KtB = lds + 32768, *Vt = lds + 65536;
        const int fr = lane & 15, fq = lane >> 4;
        for (int rep = 0; rep < REPS(3); ++rep)
        for (int unit = bx; unit < 2048; unit += G) {
            const int c = unit >> 2, h = unit & 3; const size_t tok0 = (size_t)c * 128;
            const float l2f = -log2f(1.f + __expf(-ret_decay_f[h])), l2b = -log2f(1.f + __expf(-ret_decay_b[h]));
#pragma unroll
            for (int i = 0; i < 4; ++i) { const int p = tid + 512 * i, dch = p & 15, m = p >> 4;
                const bf16x8 kr = *reinterpret_cast<const bf16x8*>(RK + (tok0 + m) * 512 + h * 128 + dch * 8);
                const bf16x8 vr = *reinterpret_cast<const bf16x8*>(RV + (tok0 + m) * 512 + h * 128 + dch * 8);
                const float df = exp2f(l2f * (float)(127 - m)), db = exp2f(l2b * (float)m);
#pragma unroll
                for (int j = 0; j < 8; ++j) { const int d = dch * 8 + j; const float kf = bf2f((unsigned short)kr[j]);
                    *(bf16_t*)(KtF + tbyte(d, m)) = (bf16_t)f2bf(kf * df); *(bf16_t*)(KtB + tbyte(d, m)) = (bf16_t)f2bf(kf * db); *(bf16_t*)(Vt + tbyte(d, m)) = (bf16_t)vr[j]; } }
            __syncthreads();
            f32x4 af[8], ab[8];
#pragma unroll
            for (int n = 0; n < 8; ++n) { af[n] = (f32x4){0.f, 0.f, 0.f, 0.f}; ab[n] = (f32x4){0.f, 0.f, 0.f, 0.f}; }
#pragma unroll
            for (int ks = 0; ks < 4; ++ks) { const bf16x8 a_f = lds_frag(KtF, 16 * wave + fr, 32 * ks + 8 * fq), a_b = lds_frag(KtB, 16 * wave + fr, 32 * ks + 8 * fq);
#pragma unroll
                for (int n = 0; n < 8; ++n) { const bf16x8 b = lds_frag(Vt, 16 * n + fr, 32 * ks + 8 * fq); af[n] = MFMA16(a_f, b, af[n]); ab[n] = MFMA16(a_b, b, ab[n]); } }
            bf16_t* stf = ST + (size_t)(unit * 2) * 16384; bf16_t* stb = stf + 16384;
#pragma unroll
            for (int n = 0; n < 8; ++n) { const int e = 16 * n + fr, d = 16 * wave + 4 * fq;
                *(u32x2*)(stf + e * 128 + d) = (u32x2){pk2(af[n][0], af[n][1]), pk2(af[n][2], af[n][3])};
                *(u32x2*)(stb + e * 128 + d) = (u32x2){pk2(ab[n][0], ab[n][1]), pk2(ab[n][2], ab[n][3])}; }
            __syncthreads();
        }
    }
    GSYNC();

    for (int w = bx * 512 + tid; w < 48 * 8192; w += G * 512) {
        const int q = w >> 13, e2 = w & 8191, seg = q >> 3, h = (q >> 1) & 3, dir = q & 1;
        const int nch = seg < 2 ? 128 : 64, ch0 = seg < 2 ? seg * 128 : 256 + (seg - 2) * 64;
        const float lg2 = -log2f(1.f + __expf(-(dir ? ret_decay_b[h] : ret_decay_f[h]))); const float dec = exp2f(lg2 * 128.f);
        unsigned* base = (unsigned*)ST + ((size_t)(ch0 * 4 + h) * 2 + dir) * 8192 + e2;
        const long stride = dir ? -(long)(4 * 2 * 8192) : (long)(4 * 2 * 8192);
        unsigned* p = dir ? base + (size_t)(nch - 1) * (4 * 2 * 8192) : base;
        float s0 = 0.f, s1 = 0.f;
        for (int i = 0; i < nch; i += 4) {
            unsigned kv[4];
#pragma unroll
            for (int j = 0; j < 4; ++j) kv[j] = p[j * stride];
#pragma unroll
            for (int j = 0; j < 4; ++j) { p[j * stride] = pk2(s0, s1); s0 = s0 * dec + bf2f((unsigned short)(kv[j] & 0xffffu)); s1 = s1 * dec + bf2f((unsigned short)(kv[j] >> 16)); }
            p += 4 * stride;
        }
    }
    GSYNC();

    {
        char *Qs = lds, *Ks = lds + 32768, *Vt = lds + 65536, *Ps = lds + 98304;
        int tid_l = threadIdx.x; asm volatile("" : "+v"(tid_l));
        const int tid = tid_l, lane = tid & 63, wave = tid >> 6;
        const int fr = lane & 15, fq = lane >> 4;
        for (int rep = 0; rep < REPS(5); ++rep)
        for (int unit = bx; unit < 2048; unit += G) {
            const int c = unit >> 2, h = unit & 3; const size_t tok0 = (size_t)c * 128;
            const float l2f = -log2f(1.f + __expf(-ret_decay_f[h])), l2b = -log2f(1.f + __expf(-ret_decay_b[h]));
#pragma unroll
            for (int i = 0; i < 4; ++i) { const int p = tid + 512 * i, ch = p & 15, r = p >> 4;
                const size_t go = (tok0 + r) * 512 + h * 128 + ch * 8;
                *(bf16x8*)(Qs + tbyte(r, ch * 8)) = *reinterpret_cast<const bf16x8*>(RQ + go);
                *(bf16x8*)(Ks + tbyte(r, ch * 8)) = *reinterpret_cast<const bf16x8*>(RK + go);
                const bf16x8 vr = *reinterpret_cast<const bf16x8*>(RV + go);
#pragma unroll
                for (int j = 0; j < 8; ++j) *(bf16_t*)(Vt + tbyte(ch * 8 + j, r)) = (bf16_t)vr[j]; }
            __syncthreads();
            bf16x8 aq[4];
#pragma unroll
            for (int ks = 0; ks < 4; ++ks) aq[ks] = lds_frag(Qs, 16 * wave + fr, 32 * ks + 8 * fq);
#pragma unroll 1
            for (int jm = 0; jm < 8; ++jm) { f32x4 s = (f32x4){0.f, 0.f, 0.f, 0.f};
#pragma unroll
                for (int ks = 0; ks < 4; ++ks) s = MFMA16(aq[ks], lds_frag(Ks, 16 * jm + fr, 32 * ks + 8 * fq), s);
                const int ml = 16 * jm + fr;
#pragma unroll
                for (int r = 0; r < 4; ++r) { const int nl = 16 * wave + 4 * fq + r, diff = nl - ml;
                    const float dv = diff >= 0 ? exp2f(l2f * (float)diff) : exp2f(l2b * (float)(-diff));
                    *(bf16_t*)(Ps + tbyte(nl, ml)) = (bf16_t)f2bf(s[r] * dv); } }
            asm volatile("s_waitcnt lgkmcnt(0)" ::: "memory");
            f32x4 o[8];
#pragma unroll
            for (int je = 0; je < 8; ++je) o[je] = (f32x4){0.f, 0.f, 0.f, 0.f};
#pragma unroll
            for (int ks = 0; ks < 4; ++ks) { const bf16x8 ap = lds_frag(Ps, 16 * wave + fr, 32 * ks + 8 * fq);
#pragma unroll
                for (int je = 0; je < 8; ++je) o[je] = MFMA16(ap, lds_frag(Vt, 16 * je + fr, 32 * ks + 8 * fq), o[je]);
                asm volatile("" ::: "memory"); }
            __syncthreads();
            { const bf16_t* stf = ST + (size_t)(unit * 2) * 16384; const bf16_t* stb = stf + 16384;
#pragma unroll
              for (int i = 0; i < 4; ++i) { const int p = tid + 512 * i, ch = p & 15, r = p >> 4;
                  *(bf16x8*)(Qs + tbyte(r, ch * 8)) = *reinterpret_cast<const bf16x8*>(stf + r * 128 + ch * 8);
                  *(bf16x8*)(Ks + tbyte(r, ch * 8)) = *reinterpret_cast<const bf16x8*>(stb + r * 128 + ch * 8); } }
            __syncthreads();
            float dqf[4], dqb[4];
#pragma unroll
            for (int r = 0; r < 4; ++r) { const int nl = 16 * wave + 4 * fq + r; dqf[r] = exp2f(l2f * (float)(nl + 1)); dqb[r] = exp2f(l2b * (float)(128 - nl)); }
#pragma unroll
            for (int je = 0; je < 8; ++je) { f32x4 xf = (f32x4){0.f, 0.f, 0.f, 0.f}, xb = (f32x4){0.f, 0.f, 0.f, 0.f};
#pragma unroll
                for (int ks = 0; ks < 4; ++ks) { xf = MFMA16(aq[ks], lds_frag(Qs, 16 * je + fr, 32 * ks + 8 * fq), xf); xb = MFMA16(aq[ks], lds_frag(Ks, 16 * je + fr, 32 * ks + 8 * fq), xb); }
#pragma unroll
                for (int r = 0; r < 4; ++r) o[je][r] += dqf[r] * xf[r] + dqb[r] * xb[r];
                asm volatile("" ::: "memory"); }
#pragma unroll
            for (int r = 0; r < 4; ++r) { float s = 0.f;
#pragma unroll
                for (int je = 0; je < 8; ++je) s += o[je][r];
                s += __shfl_xor(s, 1); s += __shfl_xor(s, 2); s += __shfl_xor(s, 4); s += __shfl_xor(s, 8);
                const float mean = s * (1.f / 128.f); float q = 0.f;
#pragma unroll
                for (int je = 0; je < 8; ++je) { const float d = o[je][r] - mean; q += d * d; }
                q += __shfl_xor(q, 1); q += __shfl_xor(q, 2); q += __shfl_xor(q, 4); q += __shfl_xor(q, 8);
                const float rstd = 1.f / sqrtf(q * (1.f / 128.f) + LN_EPS);
                const size_t t = tok0 + 16 * wave + 4 * fq + r;
#pragma unroll
                for (int je = 0; je < 8; ++je) { const int e = 16 * je + fr; const float gt = bf2f(RG[t * 512 + h * 128 + e]);
                    MIX[t * 1024 + h * 128 + e] = (bf16_t)f2bf((o[je][r] - mean) * rstd * ret_gn_w[h * 128 + e] * gt); } }
            __syncthreads();
        }
    }
    GSYNC();

    for (int rep = 0; rep < REPS(6); ++rep)
    for (int m = gw; m < NTOK; m += NGW) {
        const bf16_t* row = CB + (size_t)m * 768;
        float sq = 0.f, skv = 0.f;
        if (lane < 48) { const bf16x8 v = *reinterpret_cast<const bf16x8*>(row + lane * 8);
#pragma unroll
            for (int j = 0; j < 8; ++j) { const float f = bf2f((unsigned short)v[j]); sq += f * f; } }
        if (lane < 32) { const bf16x8 v = *reinterpret_cast<const bf16x8*>(row + 384 + lane * 8);
#pragma unroll
            for (int j = 0; j < 8; ++j) { const float f = bf2f((unsigned short)v[j]); skv += f * f; } }
        sq = wave_sum(sq); skv = wave_sum(skv);
        if (lane == 0) { rstdq[m] = 1.f / sqrtf(sq * (1.f / 384.f) + RMS_EPS); rstdkv[m] = 1.f / sqrtf(skv * (1.f / 256.f) + RMS_EPS); }
        if (lane < 32) { const int pos = tok_pos(m); const float x1 = bf2f(row[640 + lane]), x2 = bf2f(row[672 + lane]);
            const float c = cos32[(size_t)pos * 32 + lane], s = sin32[(size_t)pos * 32 + lane];
            KPE[(size_t)m * 64 + lane] = (bf16_t)f2bf(x1 * c - x2 * s); KPE[(size_t)m * 64 + 32 + lane] = (bf16_t)f2bf(x1 * s + x2 * c); }
    }
    GSYNC();

    {
        pg8::Gemm g{CB, WuqT, NTOK, 512, 384, 768}; pg8::StaticOrder S; S.init(NTOK, 512, G, bx);
        EpiBf16<2> E{Qb, 768, nullptr};
        pg8::gemm_phase<EpiBf16<2>>(lds3, g, S, E);
    }
    {
        pg8::Gemm g{CB, WuqT + (size_t)512 * 384, NTOK, 256, 384, 768}; pg8::StaticOrder S; S.init(NTOK, 256, G, bx);
        EpiQR E{Qb, cos32, sin32};
        pg8::gemm_phase<EpiQR>(lds3, g, S, E);
    }
    {
        pg8::Gemm g{CB + 384, WukvT, NTOK, 1024, 256, 768}; pg8::StaticOrder S; S.init(NTOK, 1024, G, bx);
        EpiBf16<0> E{KVb, 1024, rstdkv};
        pg8::gemm_phase<EpiBf16<0>>(lds3, g, S, E);
    }
    GSYNC();

    {
        const int vcu = (G == 256) ? (bx & 7) * 32 + (bx >> 3) : bx;
        for (int rep = 0; rep < REPS(8); ++rep)
        for (int U = vcu; U < 1024; U += G) {
            const int round = U >> 8, v = U & 255; int seg, h, qb, seq; size_t tok0;
            if (round < 2) { const int pair = v >> 5; seg = pair >> 2; h = pair & 3; qb = (v & 31) + 32 * round; seq = 16384; tok0 = (size_t)seg * 16384; }
            else { const int pair = (v >> 5) + 8 * (round - 2); seg = 2 + (pair >> 2); h = pair & 3; qb = v & 31; seq = 8192; tok0 = 32768 + (size_t)(seg - 2) * 8192; }
            const size_t q0 = tok0 + (size_t)qb * 256;
            att::attn_unit(Qb + q0 * 768 + h * 128, Qb + q0 * 768 + 512 + h * 64, rstdq + q0, KVb + tok0 * 1024 + h * 256, KVb + tok0 * 1024 + h * 256 + 128, KPE + tok0 * 64,
                           MIX + q0 * 1024 + 512 + h * 128, seq, lds);
        }
    }
    GSYNC();

    for (int rep = 0; rep < REPS(9); ++rep) {
        pg8::Gemm g{MIX, WoT, NTOK, DM, DM, DM}; pg8::StaticOrder S; S.init(NTOK, DM, G, bx);
        EpiResid E{x_prompt, x_sample, out, mod + 2 * 1024, 0};
        pg8::gemm_phase<EpiResid>(lds3, g, S, E);
    }
    GSYNC();

    for (int m = gw; m < NTOK; m += NGW) {
        const float* md = mod + (size_t)tok_seg(m) * NMOD;
        f32x4* yr = (f32x4*)(out + (size_t)m * DM) + lane;
        f32x4 v[4]; float s = 0.f;
#pragma unroll
        for (int j = 0; j < 4; ++j) { v[j] = yr[64 * j]; s += (v[j].x + v[j].y) + (v[j].z + v[j].w); }
        float mean = wave_sum(s) * (1.f / DM); float s2 = 0.f;
#pragma unroll
        for (int j = 0; j < 4; ++j) { v[j] = v[j] - mean; s2 += (v[j].x * v[j].x + v[j].y * v[j].y) + (v[j].z * v[j].z + v[j].w * v[j].w); }
        float rstd = 1.f / sqrtf(wave_sum(s2) * (1.f / DM) + LN_EPS);
        s = 0.f;
#pragma unroll
        for (int j = 0; j < 4; ++j) { const int c = 4 * lane + 256 * j; v[j] = v[j] * rstd * *(const f32x4*)(ln1_w + c) + *(const f32x4*)(ln1_b + c); yr[64 * j] = v[j]; s += (v[j].x + v[j].y) + (v[j].z + v[j].w); }
        mean = wave_sum(s) * (1.f / DM); s2 = 0.f;
#pragma unroll
        for (int j = 0; j < 4; ++j) { v[j] = v[j] - mean; s2 += (v[j].x * v[j].x + v[j].y * v[j].y) + (v[j].z * v[j].z + v[j].w * v[j].w); }
        rstd = 1.f / sqrtf(wave_sum(s2) * (1.f / DM) + LN_EPS);
        u32x2* o8 = (u32x2*)(XN + (size_t)m * DM) + lane;
#pragma unroll
        for (int j = 0; j < 4; ++j) { const int c = 4 * lane + 256 * j; const f32x4 sh = *(const f32x4*)(md + 3072 + c), sc = *(const f32x4*)(md + 4096 + c);
            const f32x4 h = v[j] * rstd * (sc + 1.f) + sh; o8[64 * j] = (u32x2){pk2(h.x, h.y), pk2(h.z, h.w)}; }
    }
    GSYNC();

    for (int slab = 0; slab < 4; ++slab) {
        const int r0 = slab * 16384;
        for (int rep = 0; rep < REPS(11); ++rep) {
            pg8::Gemm g{XN + (size_t)r0 * DM, WupT, 16384, FF, DM, DM}; pg8::StaticOrder S; S.init(16384, FF, G, bx);
            EpiBf16<1> E{Hb, FF, nullptr};
            pg8::gemm_phase<EpiBf16<1>>(lds3, g, S, E);
        }
        GSYNC();
        {
            pg8::Gemm g{Hb, WdnT, 16384, DM, FF, FF}; pg8::StaticOrder S; S.init(16384, DM, G, bx);
            EpiResid E{nullptr, nullptr, out, mod + 5 * 1024, r0};
            pg8::gemm_phase<EpiResid>(lds3, g, S, E);
        }
        GSYNC();
    }

    for (int m = gw; m < NTOK; m += NGW) {
        f32x4* yr = (f32x4*)(out + (size_t)m * DM) + lane;
        f32x4 v[4]; float s = 0.f;
#pragma unroll
        for (int j = 0; j < 4; ++j) { v[j] = yr[64 * j]; s += (v[j].x + v[j].y) + (v[j].z + v[j].w); }
        const float mean = wave_sum(s) * (1.f / DM); float s2 = 0.f;
#pragma unroll
        for (int j = 0; j < 4; ++j) { v[j] = v[j] - mean; s2 += (v[j].x * v[j].x + v[j].y * v[j].y) + (v[j].z * v[j].z + v[j].w * v[j].w); }
        const float rstd = 1.f / sqrtf(wave_sum(s2) * (1.f / DM) + LN_EPS);
#pragma unroll
        for (int j = 0; j < 4; ++j) { const int c = 4 * lane + 256 * j; yr[64 * j] = v[j] * rstd * *(const f32x4*)(ln2_w + c) + *(const f32x4*)(ln2_b + c); }
    }
}

extern "C" void kernel_launch(void* const* d_in, const int* in_sizes, int n_in, void* d_out, int out_size, void* d_ws, size_t ws_size, hipStream_t stream) {
    constexpr int LDS_BYTES = 147456;
    static int grid = 0;
    if (grid == 0) {
        if (n_in != 21 || out_size != NTOK * DM || ws_size < WS_END) { fprintf(stderr, "kernel_launch: unexpected shapes (n_in %d out %d ws %zu)\n", n_in, out_size, ws_size); grid = -1; return; }
        int dev = 0, cus = 0, per_cu = 0;
        (void)hipGetDevice(&dev);
        (void)hipDeviceGetAttribute(&cus, hipDeviceAttributeMultiprocessorCount, dev);
        (void)hipFuncSetAttribute((const void*)fwd_kernel, hipFuncAttributeMaxDynamicSharedMemorySize, LDS_BYTES);
        (void)hipOccupancyMaxActiveBlocksPerMultiprocessor(&per_cu, (const void*)fwd_kernel, 512, LDS_BYTES);
        if (per_cu < 1) per_cu = 1;
        grid = cus * per_cu;
    }
    if (grid < 0) return;
    (void)hipMemsetAsync((unsigned char*)d_ws + WS_BAR, 0, XCD_BAR_WORDS * 4, stream);
    Args a{};
    for (int i = 0; i < 21; ++i) a.in[i] = (const float*)d_in[i];
    a.out = (float*)d_out; a.ws = (unsigned char*)d_ws;
    void* args[] = {&a};
    hipError_t e = hipLaunchCooperativeKernel((const void*)fwd_kernel, dim3(grid), dim3(512), args, LDS_BYTES, stream);
    if (e != hipSuccess) fprintf(stderr, "cooperative launch failed: %s (grid %d)\n", hipGetErrorString(e), grid);
}
```
